# Optimizing an MI355X kernel written in HIP

```python
import jax, jax.numpy as jnp
from jax import lax
import numpy as np

D_MODEL = 1024
BATCH = 8
SEQ = 4096
DEPTH = 1

N_HEADS = 8
N_KV = 2
HEAD_DIM = 64
GQA_R = N_HEADS // N_KV
NSA_WIDTH = N_HEADS * HEAD_DIM
KV_WIDTH = N_KV * HEAD_DIM
CMP_BLOCK = 32
CMP_STRIDE = 16
SEL_BLOCK = 64
SEL_TOPK = 16
N_FORCED_LOCAL = 2
WINDOW = 512
QBLK = 128
FORCE_SCORE = 1e9
POOL_SIZES = (2, 4, 8, 16)
POOL_GROUP = 128
POOL_WIDTH = POOL_GROUP * len(POOL_SIZES)
D_FF = 4 * D_MODEL
ROPE_THETA = 10000.0
EPS = 1e-6
N_MOD = 6
IN_SIZES = (NSA_WIDTH, KV_WIDTH, KV_WIDTH, KV_WIDTH, KV_WIDTH, KV_WIDTH, KV_WIDTH,
            3 * N_HEADS, POOL_WIDTH, 2 * D_MODEL)
IN_WIDTH = int(sum(IN_SIZES))
IN_SPLITS = [int(v) for v in np.cumsum(IN_SIZES)[:-1]]

kernel_name = "hybrid_nsa_pool_block"


def rms_norm(x, g):
    xf = x.astype(jnp.float32)
    y = xf * lax.rsqrt(jnp.mean(xf * xf, axis=-1, keepdims=True) + EPS)
    return (y * g.astype(jnp.float32)).astype(x.dtype)


def rope(x):
    s = x.shape[1]
    half = HEAD_DIM // 2
    inv = ROPE_THETA ** (-jnp.arange(half, dtype=jnp.float32) / half)
    ang = jnp.arange(s, dtype=jnp.float32)[:, None] * inv[None, :]
    cos = jnp.cos(ang)[None, :, None, :]
    sin = jnp.sin(ang)[None, :, None, :]
    xf = x.astype(jnp.float32)
    x1, x2 = xf[..., :half], xf[..., half:]
    return jnp.concatenate([x1 * cos - x2 * sin, x2 * cos + x1 * sin], axis=-1).astype(x.dtype)


def masked_softmax(s, mask):
    s = jnp.where(mask, s.astype(jnp.float32), -jnp.inf)
    m = jnp.max(s, axis=-1, keepdims=True)
    m = jnp.where(jnp.isfinite(m), m, 0.0)
    e = jnp.exp(s - m)
    return e / jnp.maximum(jnp.sum(e, axis=-1, keepdims=True), 1e-30)


def compress(k, pe, w1, w2):
    b, s, g, dh = k.shape
    n_cmp = (s - CMP_BLOCK) // CMP_STRIDE + 1
    idx = np.arange(n_cmp)[:, None] * CMP_STRIDE + np.arange(CMP_BLOCK)[None, :]
    blk = k[:, idx] + pe[None, None, :, None, :]
    blk = blk.transpose(0, 1, 3, 2, 4).reshape(b, n_cmp, g, CMP_BLOCK * dh)
    return jax.nn.gelu(blk @ w1) @ w2


def nsa_attention(q, kc, vc, ks, vs, kw, vw, gate_logits):
    b, s = q.shape[0], q.shape[1]
    nq = s // QBLK
    n_cmp = kc.shape[1]
    n_sel = s // SEL_BLOCK
    topk = min(SEL_TOPK, n_sel)
    scale = HEAD_DIM ** -0.5
    cmp_start = np.arange(n_cmp) * CMP_STRIDE
    cmp_end = jnp.asarray(cmp_start + CMP_BLOCK - 1)
    sel_start = np.arange(n_sel) * SEL_BLOCK
    overlap = jnp.asarray(((cmp_start[:, None] < sel_start[None, :] + SEL_BLOCK) &
                           (cmp_start[:, None] + CMP_BLOCK > sel_start[None, :])).astype(np.float32))
    ks_blk = ks.reshape(b, n_sel, SEL_BLOCK, N_KV, HEAD_DIM).transpose(0, 3, 1, 2, 4)
    vs_blk = vs.reshape(b, n_sel, SEL_BLOCK, N_KV, HEAD_DIM).transpose(0, 3, 1, 2, 4)
    pad = ((0, 0), (WINDOW, 0), (0, 0), (0, 0))
    kw_pad = jnp.pad(kw, pad)
    vw_pad = jnp.pad(vw, pad)
    q_blocks = q.reshape(b, nq, QBLK, N_KV, GQA_R, HEAD_DIM).transpose(1, 0, 2, 3, 4, 5)
    g_blocks = gate_logits.reshape(b, nq, QBLK, N_HEADS, 3).transpose(1, 0, 2, 3, 4)
    bi = jnp.arange(b)[:, None, None, None]
    gi = jnp.arange(N_KV)[None, :, None, None]
    blk_id = jnp.arange(n_sel)

    def one_block(args):
        qb, gb, c = args
        t = c * QBLK + jnp.arange(QBLK)
        sc = jnp.einsum('bqgrd,bngd->bgrqn', qb, kc) * scale
        p_cmp = masked_softmax(sc, cmp_end[None, :] <= t[:, None])
        o_cmp = jnp.einsum('bgrqn,bngd->bqgrd', p_cmp.astype(vc.dtype), vc)
        imp = jnp.einsum('bgrqn,nm->bgqm', p_cmp, overlap)
        cur = t // SEL_BLOCK
        causal_blk = blk_id[None, :] <= cur[:, None]
        forced = (blk_id[None, :] == 0) | (causal_blk & (blk_id[None, :] > cur[:, None] - N_FORCED_LOCAL))
        imp = jnp.where(forced, FORCE_SCORE, jnp.where(causal_blk, imp, -jnp.inf))
        _, idx = lax.top_k(imp, topk)
        kg = ks_blk[bi, gi, idx].reshape(b, N_KV, QBLK, topk * SEL_BLOCK, HEAD_DIM)
        vg = vs_blk[bi, gi, idx].reshape(b, N_KV, QBLK, topk * SEL_BLOCK, HEAD_DIM)
        kpos = (idx[..., None] * SEL_BLOCK + jnp.arange(SEL_BLOCK)).reshape(b, N_KV, QBLK, topk * SEL_BLOCK)
        sel_mask = (kpos <= t[None, None, :, None])[:, :, None]
        ss = jnp.einsum('bqgrd,bgqjd->bgrqj', qb, kg) * scale
        p_sel = masked_softmax(ss, sel_mask)
        o_sel = jnp.einsum('bgrqj,bgqjd->bqgrd', p_sel.astype(vg.dtype), vg)
        kwb = lax.dynamic_slice_in_dim(kw_pad, c * QBLK, QBLK + WINDOW, axis=1)
        vwb = lax.dynamic_slice_in_dim(vw_pad, c * QBLK, QBLK + WINDOW, axis=1)
        kp = c * QBLK - WINDOW + jnp.arange(QBLK + WINDOW)
        wmask = (kp[None, :] <= t[:, None]) & (kp[None, :] > t[:, None] - WINDOW) & (kp[None, :] >= 0)
        sw = jnp.einsum('bqgrd,bjgd->bgrqj', qb, kwb) * scale
        p_win = masked_softmax(sw, wmask)
        o_win = jnp.einsum('bgrqj,bjgd->bqgrd', p_win.astype(vwb.dtype), vwb)
        g = jax.nn.sigmoid(gb.astype(jnp.float32)).reshape(b, QBLK, N_KV, GQA_R, 3).astype(qb.dtype)
        return g[..., 0:1] * o_cmp + g[..., 1:2] * o_sel + g[..., 2:3] * o_win

    out = lax.map(one_block, (q_blocks, g_blocks, jnp.arange(nq)))
    return out.transpose(1, 0, 2, 3, 4, 5).reshape(b, s, NSA_WIDTH)


def pool_mixer(u, w_pool, pool_scale):
    b, s, _ = u.shape
    uf = u.astype(jnp.float32)
    cs = jnp.concatenate([jnp.zeros((b, 1, POOL_WIDTH), jnp.float32), jnp.cumsum(uf, axis=1)], axis=1)
    t = np.arange(s)
    outs = []
    for gidx, w in enumerate(POOL_SIZES):
        sl = slice(gidx * POOL_GROUP, (gidx + 1) * POOL_GROUP)
        start = np.maximum(t + 1 - w, 0)
        cnt = jnp.asarray((t + 1 - start).astype(np.float32))[None, :, None]
        mean = (cs[:, t + 1, sl] - cs[:, start, sl]) / cnt
        outs.append(mean - uf[:, :, sl])
    pooled = jnp.stack(outs, axis=2).astype(u.dtype)
    mixed = jnp.einsum('bsgc,gcd->bsgd', pooled, w_pool).reshape(b, s, POOL_WIDTH)
    return mixed * pool_scale


def setup_inputs(seed: int = 0) -> dict:
    key = jax.random.key(seed)
    ks = jax.random.split(key, 24)
    n = lambda k, shape, s: jax.random.normal(k, shape, jnp.float32) * s
    L = DEPTH
    return {
        "x": n(ks[0], (BATCH, SEQ, D_MODEL), 1.0),
        "c": n(ks[1], (BATCH, D_MODEL), 1.0),
        "w_ada": n(ks[2], (L, D_MODEL, N_MOD * D_MODEL), D_MODEL ** -0.5),
        "b_ada": n(ks[3], (L, N_MOD * D_MODEL), 0.02),
        "g_pre_mix": 1.0 + n(ks[4], (L, D_MODEL), 0.05),
        "g_post_mix": 1.0 + n(ks[5], (L, D_MODEL), 0.05),
        "w_in": n(ks[6], (L, D_MODEL, IN_WIDTH), D_MODEL ** -0.5),
        "cmp_pe_k": n(ks[7], (L, CMP_BLOCK, HEAD_DIM), 0.1),
        "cmp_w1_k": n(ks[8], (L, CMP_BLOCK * HEAD_DIM, HEAD_DIM), (CMP_BLOCK * HEAD_DIM) ** -0.5),
        "cmp_w2_k": n(ks[9], (L, HEAD_DIM, HEAD_DIM), HEAD_DIM ** -0.5),
        "cmp_pe_v": n(ks[10], (L, CMP_BLOCK, HEAD_DIM), 0.1),
        "cmp_w1_v": n(ks[11], (L, CMP_BLOCK * HEAD_DIM, HEAD_DIM), (CMP_BLOCK * HEAD_DIM) ** -0.5),
        "cmp_w2_v": n(ks[12], (L, HEAD_DIM, HEAD_DIM), HEAD_DIM ** -0.5),
        "w_pool": n(ks[13], (L, len(POOL_SIZES), POOL_GROUP, POOL_GROUP), POOL_GROUP ** -0.5),
        "pool_scale": 1.0 + n(ks[14], (L, POOL_WIDTH), 0.1),
        "w_br_nsa": n(ks[15], (L, NSA_WIDTH, D_MODEL), NSA_WIDTH ** -0.5),
        "w_br_pool": n(ks[16], (L, POOL_WIDTH, D_MODEL), POOL_WIDTH ** -0.5),
        "w_out": n(ks[17], (L, D_MODEL, D_MODEL), D_MODEL ** -0.5),
        "g_pre_mlp": 1.0 + n(ks[18], (L, D_MODEL), 0.05),
        "g_post_mlp": 1.0 + n(ks[19], (L, D_MODEL), 0.05),
        "w_fc1": n(ks[20], (L, D_MODEL, D_FF), D_MODEL ** -0.5),
        "w_fc2": n(ks[21], (L, D_FF, D_MODEL), D_FF ** -0.5),
    }


def reference(x, c, w_ada, b_ada, g_pre_mix, g_post_mix, w_in, cmp_pe_k, cmp_w1_k, cmp_w2_k,
              cmp_pe_v, cmp_w1_v, cmp_w2_v, w_pool, pool_scale, w_br_nsa, w_br_pool, w_out,
              g_pre_mlp, g_post_mlp, w_fc1, w_fc2):
    b, s, _ = x.shape
    for l in range(DEPTH):
        mod = (jax.nn.silu(c) @ w_ada[l] + b_ada[l]).astype(x.dtype)[:, None, :]
        sh1, sc1, gt1, sh2, sc2, gt2 = jnp.split(mod, N_MOD, axis=-1)

        h = rms_norm(x, g_pre_mix[l]) * (1.0 + sc1) + sh1
        proj = h @ w_in[l]
        q, kc, vc, ksl, vsl, kwn, vwn, nsa_g, u, br_g = jnp.split(proj, IN_SPLITS, axis=-1)
        kv = lambda a: a.reshape(b, s, N_KV, HEAD_DIM)
        q = rope(q.reshape(b, s, N_HEADS, HEAD_DIM))
        kc_c = compress(rope(kv(kc)), cmp_pe_k[l], cmp_w1_k[l], cmp_w2_k[l])
        vc_c = compress(kv(vc), cmp_pe_v[l], cmp_w1_v[l], cmp_w2_v[l])
        o_nsa = nsa_attention(q, kc_c, vc_c, rope(kv(ksl)), kv(vsl), rope(kv(kwn)), kv(vwn),
                              nsa_g.reshape(b, s, N_HEADS, 3))
        o_pool = pool_mixer(u, w_pool[l], pool_scale[l])
        gate_a, gate_b = jnp.split(jax.nn.sigmoid(br_g), 2, axis=-1)
        merged = gate_a * (o_nsa @ w_br_nsa[l]) + gate_b * (o_pool @ w_br_pool[l])
        y = merged @ w_out[l]
        x = x + gt1 * rms_norm(y, g_post_mix[l])

        h = rms_norm(x, g_pre_mlp[l]) * (1.0 + sc2) + sh2
        y = jnp.square(jax.nn.relu(h @ w_fc1[l])) @ w_fc2[l]
        x = x + gt2 * rms_norm(y, g_post_mlp[l])
    return x
```

```cpp
#include <hip/hip_runtime.h>
#include <hip/hip_cooperative_groups.h>
#include <cstdio>
#include <cstdint>
namespace cg = cooperative_groups;

#ifndef MK_N_LAUNCHES
#define MK_N_LAUNCHES 1
#endif

namespace pg8 {
#define PG8_LAS __attribute__((address_space(3)))
typedef unsigned short bf16_t;
typedef short bf16x8 __attribute__((ext_vector_type(8)));
typedef float f32x4 __attribute__((ext_vector_type(4)));
typedef unsigned u32x4 __attribute__((ext_vector_type(4)));
constexpr int BM = 256, BK = 64, HALF = 128, HTB = HALF * BK * 2  , STAGE_BYTES = 8 * HTB, NXCD = 8, WGM = 8;

__host__ __device__ __forceinline__ int lds_byte(int r, int c) { const int st = (r >> 4) * 2 + (c >> 5), rr = r & 15, cc = c & 31, ob = rr * 64 + cc * 2; return st * 1024 + (ob ^ (((ob >> 9) & 1) << 5)); }
__host__ __device__ __forceinline__ void stage_rc(int b, int& R, int& C) { const int st = b / 1024, sb = b % 1024, swz = sb ^ (((sb >> 9) & 1) << 5); R = (st >> 1) * 16 + swz / 64; C = (st & 1) * 32 + (swz % 64) / 2; }
__host__ __device__ __forceinline__ int perm32(int rho) { const int n = rho >> 4, i = rho & 15; return 8 * (i >> 2) + 4 * n + (i & 3); }

struct Unit { int pm, pn; };
struct Gemm { const bf16_t* A; const bf16_t* Bt; int M, N, K; };

struct StaticOrder {
    int nM, nN, nwg, G, c;
    __host__ __device__ void init(int M, int N, int G_, int c_) { nM = M / BM; nN = N / BM; nwg = nM * nN; G = G_; c = c_; }
    __host__ __device__ bool next(int i, Unit& u) const {
        const long L = (long)i * G + c; if (L >= nwg) return false;
        int wgid = (int)L; { const int q = nwg / NXCD, r = nwg % NXCD, xcd = wgid % NXCD, off = wgid / NXCD; wgid = (xcd < r ? xcd * (q + 1) : r * (q + 1) + (xcd - r) * q) + off; }
        const int nig = WGM * nN, gid = wgid / nig, fm = gid * WGM, gsz = (nM - fm) < WGM ? (nM - fm) : WGM;
        u.pm = fm + ((wgid % nig) % gsz); u.pn = (wgid % nig) / gsz; return true;
    }
    __device__ __forceinline__ void a_ready(const Unit&) const {}
    __device__ __forceinline__ void done(const Unit&) const {}
};

__device__ __forceinline__ unsigned cvt_pk_bf16(float lo, float hi) { unsigned r; asm volatile("v_cvt_pk_bf16_f32 %0, %1, %2" : "=v"(r) : "v"(lo), "v"(hi)); return r; }
__device__ __forceinline__ float bflo(unsigned w) { return __uint_as_float(w << 16); }
__device__ __forceinline__ float bfhi(unsigned w) { return __uint_as_float(w & 0xffff0000u); }
__device__ __forceinline__ float sigm(float x) { return 1.f / (1.f + __expf(-x)); }
__device__ __forceinline__ u32x4 pack8(const f32x4& a, const f32x4& b) { u32x4 w; w.x = cvt_pk_bf16(a[0], a[1]); w.y = cvt_pk_bf16(a[2], a[3]); w.z = cvt_pk_bf16(b[0], b[1]); w.w = cvt_pk_bf16(b[2], b[3]); return w; }

struct EpiProj {
    static constexpr bool PERM = true, AFTER_DRAIN = false;
    bf16_t *Q, *KV6, *U, *BRG; float* NG; const float *COS, *SIN; float qscale;
    __device__ __forceinline__ void operator()(const f32x4 (&acc)[2][2][4][2], const Unit& u, int wr, int wc, int fr, int fq) const {
        const int row0 = u.pm * BM + wr * 64 + fr, pn = u.pn, cl = wc * 32 + 8 * fq, i0 = (cl & 63) >> 1;
#pragma unroll
        for (int ai = 0; ai < 2; ++ai)
#pragma unroll
            for (int m = 0; m < 4; ++m) {
                const int row = row0 + ai * HALF + m * 16, t = row & 4095;
                f32x4 cs = (f32x4){1.f, 1.f, 1.f, 1.f}, sn = (f32x4){0.f, 0.f, 0.f, 0.f};
                if (pn < 5) { cs = *(const f32x4*)(COS + t * 32 + i0); sn = *(const f32x4*)(SIN + t * 32 + i0); }
#pragma unroll
                for (int bj = 0; bj < 2; ++bj) {
                    f32x4 v0 = acc[ai][bj][m][0], v1 = acc[ai][bj][m][1];
                    const int col = bj * HALF + cl;
                    if (pn < 2 || (pn < 5 && bj == 0)) {
                        f32x4 r0, r1;
                        r0[0] = v0[0] * cs[0] - v0[1] * sn[0]; r0[1] = v0[1] * cs[0] + v0[0] * sn[0];
                        r0[2] = v0[2] * cs[1] - v0[3] * sn[1]; r0[3] = v0[3] * cs[1] + v0[2] * sn[1];
                        r1[0] = v1[0] * cs[2] - v1[1] * sn[2]; r1[1] = v1[1] * cs[2] + v1[0] * sn[2];
                        r1[2] = v1[2] * cs[3] - v1[3] * sn[3]; r1[3] = v1[3] * cs[3] + v1[2] * sn[3];
                        v0 = r0; v1 = r1;
                    }
                    if (pn < 2) { v0 = v0 * qscale; v1 = v1 * qscale; *(u32x4*)(Q + (size_t)row * 512 + pn * 256 + col) = pack8(v0, v1); }
                    else if (pn < 5) { *(u32x4*)(KV6 + (size_t)row * 768 + (pn - 2) * 256 + col) = pack8(v0, v1); }
                    else if (pn < 7) { *(u32x4*)(U + (size_t)row * 512 + (pn - 5) * 256 + col) = pack8(v0, v1); }
                    else if (pn < 15) {
#pragma unroll
                        for (int j = 0; j < 4; ++j) { v0[j] = sigm(v0[j]); v1[j] = sigm(v1[j]); }
                        *(u32x4*)(BRG + (size_t)row * 2048 + (pn - 7) * 256 + col) = pack8(v0, v1);
                    } else if (bj == 0 && cl < 24) {
#pragma unroll
                        for (int j = 0; j < 4; ++j) { v0[j] = sigm(v0[j]); v1[j] = sigm(v1[j]); }
                        *(f32x4*)(NG + (size_t)row * 24 + cl) = v0; *(f32x4*)(NG + (size_t)row * 24 + cl + 4) = v1;
                    }
                }
            }
    }
};
template <int MODE> struct EpiGate {
    static constexpr bool PERM = true, AFTER_DRAIN = false;
    bf16_t* T; const bf16_t* G;
    __device__ __forceinline__ void operator()(const f32x4 (&acc)[2][2][4][2], const Unit& u, int wr, int wc, int fr, int fq) const {
        const int row0 = u.pm * BM + wr * 64 + fr, cl = u.pn * BM + wc * 32 + 8 * fq;
#pragma unroll
        for (int ai = 0; ai < 2; ++ai)
#pragma unroll
            for (int m = 0; m < 4; ++m) {
                const int row = row0 + ai * HALF + m * 16;
#pragma unroll
                for (int bj = 0; bj < 2; ++bj) {
                    const int col = bj * HALF + cl;
                    const u32x4 g = *(const u32x4*)(G + (size_t)row * 2048 + col);
                    f32x4 v0 = acc[ai][bj][m][0], v1 = acc[ai][bj][m][1];
                    v0[0] *= bflo(g.x); v0[1] *= bfhi(g.x); v0[2] *= bflo(g.y); v0[3] *= bfhi(g.y);
                    v1[0] *= bflo(g.z); v1[1] *= bfhi(g.z); v1[2] *= bflo(g.w); v1[3] *= bfhi(g.w);
                    if (MODE == 1) {
                        const u32x4 p = *(const u32x4*)(T + (size_t)row * 1024 + col);
                        v0[0] += bflo(p.x); v0[1] += bfhi(p.x); v0[2] += bflo(p.y); v0[3] += bfhi(p.y);
                        v1[0] += bflo(p.z); v1[1] += bfhi(p.z); v1[2] += bflo(p.w); v1[3] += bfhi(p.w);
                    }
                    *(u32x4*)(T + (size_t)row * 1024 + col) = pack8(v0, v1);
                }
            }
    }
};
struct EpiF32 {
    static constexpr bool PERM = false, AFTER_DRAIN = false;
    float* C; int ldc;
    __device__ __forceinline__ void operator()(const f32x4 (&acc)[2][2][4][2], const Unit& u, int wr, int wc, int fr, int fq) const {
        const int row0 = u.pm * BM + wr * 64 + fr, col0 = u.pn * BM + wc * 32 + 4 * fq;
#pragma unroll
        for (int ai = 0; ai < 2; ++ai)
#pragma unroll
            for (int m = 0; m < 4; ++m) { float* rowp = C + (size_t)(row0 + ai * HALF + m * 16) * ldc + col0;
#pragma unroll
                for (int bj = 0; bj < 2; ++bj)
#pragma unroll
                    for (int n = 0; n < 2; ++n) *(f32x4*)(rowp + bj * HALF + n * 16) = acc[ai][bj][m][n]; }
    }
};
struct EpiRelu2 {
    static constexpr bool PERM = true, AFTER_DRAIN = false;
    bf16_t* H; int ldc;
    __device__ __forceinline__ void operator()(const f32x4 (&acc)[2][2][4][2], const Unit& u, int wr, int wc, int fr, int fq) const {
        const int row0 = u.pm * BM + wr * 64 + fr, col0 = u.pn * BM + wc * 32 + 8 * fq;
#pragma unroll
        for (int ai = 0; ai < 2; ++ai)
#pragma unroll
            for (int m = 0; m < 4; ++m) { bf16_t* rowp = H + (size_t)(row0 + ai * HALF + m * 16) * ldc + col0;
#pragma unroll
                for (int bj = 0; bj < 2; ++bj) { f32x4 v0 = acc[ai][bj][m][0], v1 = acc[ai][bj][m][1];
#pragma unroll
                    for (int j = 0; j < 4; ++j) { const float a = fmaxf(v0[j], 0.f), b = fmaxf(v1[j], 0.f); v0[j] = a * a; v1[j] = b * b; }
                    *(u32x4*)(rowp + bj * HALF) = pack8(v0, v1); } }
    }
};

template <class Epi, class Sched, bool ALIGN_EPI = false, bool SP2 = false>
__device__ __forceinline__ void gemm_phase(PG8_LAS unsigned char* lds, const Gemm g, const Sched& S, const Epi& E) {
    const int tid = threadIdx.x, wid = __builtin_amdgcn_readfirstlane(tid >> 6), lane = tid & 63, wr = wid >> 2, wc = wid & 3, fr = lane & 15, fq = lane >> 4;
    const int K = g.K, nt = K / BK;
    unsigned voffA[2], voffB[2];
#pragma unroll
    for (int i = 0; i < 2; ++i) { int R, C; stage_rc(tid * 16 + i * 8192, R, C); const int Rb = Epi::PERM ? ((R & ~31) + perm32(R & 31)) : R;
        voffA[i] = (unsigned)(R * K + C) * 2u; voffB[i] = (unsigned)(Rb * K + C) * 2u; }
    const size_t kstep = (size_t)(BK * 2);
    const size_t hstep = (size_t)HALF * K * 2;
    const size_t tstep = 2 * hstep;
    const unsigned ldsw = (unsigned)wid * 1024u;
    const int aoff = lds_byte(wr * 64 + fr, fq * 8), boff = lds_byte(wc * 32 + fr, fq * 8);
#define PG8_SA(b, h) (((b) * 2 + (h)) * HTB)
#define PG8_SB(b, h) ((4 + (b) * 2 + (h)) * HTB)
#define PG8_STAGE(bufoff, gbase, voff) do { _Pragma("unroll") for (int _i = 0; _i < 2; ++_i) \
        __builtin_amdgcn_global_load_lds((const unsigned*)((const char*)(gbase) + (voff)[_i]), (PG8_LAS unsigned*)(lds + (bufoff) + ldsw + _i * 8192), 16, 0, 0); } while (0)
#define PG8_LDA(dst, b, h) do { _Pragma("unroll") for (int m = 0; m < 4; ++m) _Pragma("unroll") for (int k = 0; k < 2; ++k) dst[m][k] = *(const PG8_LAS bf16x8*)(lds + PG8_SA(b, h) + aoff + m * 2048 + k * 1024); } while (0)
#define PG8_LDB(dst, b, h) do { _Pragma("unroll") for (int n = 0; n < 2; ++n) _Pragma("unroll") for (int k = 0; k < 2; ++k) dst[n][k] = *(const PG8_LAS bf16x8*)(lds + PG8_SB(b, h) + boff + n * 2048 + k * 1024); } while (0)
#define PG8_MMA(ai, bj, At, Bt) do { __builtin_amdgcn_s_setprio(1); _Pragma("unroll") for (int m = 0; m < 4; ++m) _Pragma("unroll") for (int n = 0; n < 2; ++n) _Pragma("unroll") for (int k = 0; k < 2; ++k) \
        acc[ai][bj][m][n] = __builtin_amdgcn_mfma_f32_16x16x32_bf16(Bt[n][k], At[m][k], acc[ai][bj][m][n], 0, 0, 0); __builtin_amdgcn_s_setprio(0); } while (0)
#define PG8_WAIT_V(n) asm volatile("s_waitcnt vmcnt(" #n ")" ::: "memory")
#define PG8_WAIT_L(n) asm volatile("s_waitcnt lgkmcnt(" #n ")" ::: "memory")
#define PG8_BAR __builtin_amdgcn_s_barrier()
#define PG8_SCHED __builtin_amdgcn_sched_barrier(0)
    Unit cur, nxt; int ui = 0;
    if (!S.next(0, cur)) return;
    f32x4 acc[2][2][4][2];
#pragma unroll
    for (int a = 0; a < 2; ++a)
#pragma unroll
        for (int b = 0; b < 2; ++b)
#pragma unroll
            for (int m = 0; m < 4; ++m)
#pragma unroll
                for (int n = 0; n < 2; ++n) acc[a][b][m][n] = (f32x4){0.f, 0.f, 0.f, 0.f};
    bf16x8 At[4][2], B0[2][2], B1[2][2];
    const char* cA = (const char*)g.A + (size_t)cur.pm * tstep; const char* cB = (const char*)g.Bt + (size_t)cur.pn * tstep;
    S.a_ready(cur);
    if constexpr (SP2) {
        PG8_STAGE(PG8_SB(0, 0), cB, voffB); PG8_STAGE(PG8_SB(0, 1), cB + hstep, voffB); PG8_STAGE(PG8_SA(0, 0), cA, voffA); PG8_STAGE(PG8_SA(0, 1), cA + hstep, voffA);
        if (wr == 1) PG8_BAR;
        PG8_WAIT_V(2); PG8_BAR;
        PG8_STAGE(PG8_SB(1, 0), cB + kstep, voffB); PG8_STAGE(PG8_SA(1, 0), cA + kstep, voffA); PG8_STAGE(PG8_SB(1, 1), cB + hstep + kstep, voffB);
        PG8_WAIT_V(6); PG8_BAR;
    } else {
        PG8_STAGE(PG8_SB(0, 0), cB, voffB); PG8_STAGE(PG8_SA(0, 0), cA, voffA); PG8_STAGE(PG8_SB(0, 1), cB + hstep, voffB); PG8_STAGE(PG8_SA(0, 1), cA + hstep, voffA);
        if (wr == 1) PG8_BAR;
        PG8_WAIT_V(4); PG8_BAR;
        PG8_STAGE(PG8_SB(1, 0), cB + kstep, voffB); PG8_STAGE(PG8_SA(1, 0), cA + kstep, voffA); PG8_STAGE(PG8_SB(1, 1), cB + hstep + kstep, voffB);
        PG8_WAIT_V(6); PG8_BAR;
    }
    for (;;) {
        const bool has_next = S.next(ui + 1, nxt);
        const char* nA = has_next ? (const char*)g.A + (size_t)nxt.pm * tstep : cA; const char* nB = has_next ? (const char*)g.Bt + (size_t)nxt.pn * tstep : cB;
        for (int t = 0; t < nt; t += 2) {
            const bool last = (t == nt - 2);
            const char* a1 = cA + (size_t)(t + 1) * kstep;
            const char* a2 = last ? nA : cA + (size_t)(t + 2) * kstep; const char* b2 = last ? nB : cB + (size_t)(t + 2) * kstep;
            const char* a3 = a2 + kstep; const char* b3 = b2 + kstep;
            if (last && has_next) S.a_ready(nxt);
            if constexpr (SP2) {
            PG8_LDB(B0, 0, 0); PG8_LDB(B1, 0, 1); PG8_SCHED; PG8_LDA(At, 0, 0); PG8_STAGE(PG8_SA(1, 1), a1 + hstep, voffA);
            PG8_WAIT_V(8); PG8_WAIT_L(0); PG8_BAR; PG8_MMA(0, 0, At, B0); PG8_MMA(0, 1, At, B1); PG8_BAR; PG8_SCHED;
            PG8_LDA(At, 0, 1); PG8_STAGE(PG8_SB(0, 0), b2, voffB); PG8_STAGE(PG8_SB(0, 1), b2 + hstep, voffB); PG8_STAGE(PG8_SA(0, 0), a2, voffA);
            PG8_WAIT_V(8); PG8_WAIT_L(0); PG8_BAR; PG8_MMA(1, 0, At, B0); PG8_MMA(1, 1, At, B1); PG8_BAR; PG8_SCHED;
            PG8_LDB(B0, 1, 0); PG8_LDB(B1, 1, 1); PG8_SCHED; PG8_LDA(At, 1, 0); PG8_STAGE(PG8_SA(0, 1), a2 + hstep, voffA);
            PG8_WAIT_V(8); PG8_WAIT_L(0); PG8_BAR; PG8_MMA(0, 0, At, B0); PG8_MMA(0, 1, At, B1); PG8_BAR; PG8_SCHED;
            PG8_LDA(At, 1, 1); PG8_STAGE(PG8_SB(1, 0), b3, voffB); PG8_STAGE(PG8_SB(1, 1), b3 + hstep, voffB); PG8_STAGE(PG8_SA(1, 0), a3, voffA);
            PG8_WAIT_V(8); PG8_WAIT_L(0); PG8_BAR; PG8_MMA(1, 0, At, B0); PG8_MMA(1, 1, At, B1); PG8_BAR; PG8_SCHED;
            } else {
            PG8_LDB(B0, 0, 0); PG8_SCHED; PG8_LDA(At, 0, 0); PG8_STAGE(PG8_SA(1, 1), a1 + hstep, voffA);
            PG8_WAIT_L(8); PG8_BAR; PG8_WAIT_L(0); PG8_MMA(0, 0, At, B0); PG8_BAR; PG8_SCHED;
            PG8_LDB(B1, 0, 1); PG8_STAGE(PG8_SB(0, 0), b2, voffB);
            PG8_BAR; PG8_WAIT_L(0); PG8_MMA(0, 1, At, B1); PG8_BAR;
            PG8_LDA(At, 0, 1); PG8_STAGE(PG8_SA(0, 0), a2, voffA);
            PG8_BAR; PG8_WAIT_L(0); PG8_MMA(1, 0, At, B0); PG8_BAR; PG8_SCHED;
            PG8_STAGE(PG8_SB(0, 1), b2 + hstep, voffB);
            PG8_WAIT_V(6); PG8_BAR; PG8_MMA(1, 1, At, B1); PG8_BAR;
            PG8_LDB(B0, 1, 0); PG8_SCHED; PG8_LDA(At, 1, 0); PG8_STAGE(PG8_SA(0, 1), a2 + hstep, voffA);
            PG8_WAIT_L(8); PG8_BAR; PG8_WAIT_L(0); PG8_MMA(0, 0, At, B0); PG8_BAR; PG8_SCHED;
            PG8_LDB(B1, 1, 1); PG8_STAGE(PG8_SB(1, 0), b3, voffB);
            PG8_BAR; PG8_WAIT_L(0); PG8_MMA(0, 1, At, B1); PG8_BAR;
            PG8_LDA(At, 1, 1); PG8_STAGE(PG8_SA(1, 0), a3, voffA);
            PG8_BAR; PG8_WAIT_L(0); PG8_MMA(1, 0, At, B0); PG8_BAR; PG8_SCHED;
            PG8_STAGE(PG8_SB(1, 1), b3 + hstep, voffB);
            PG8_WAIT_V(6); PG8_BAR; PG8_MMA(1, 1, At, B1); PG8_BAR;
            }
        }
        if constexpr (ALIGN_EPI) { if (wr == 0) PG8_BAR; }
        if constexpr (!Epi::AFTER_DRAIN) { E(acc, cur, wr, wc, fr, fq); S.done(cur); }
        if (!has_next) break;
#pragma unroll
        for (int a = 0; a < 2; ++a)
#pragma unroll
            for (int b = 0; b < 2; ++b)
#pragma unroll
                for (int m = 0; m < 4; ++m)
#pragma unroll
                    for (int n = 0; n < 2; ++n) acc[a][b][m][n] = (f32x4){0.f, 0.f, 0.f, 0.f};
        cur = nxt; cA = nA; cB = nB; ++ui;
        if constexpr (ALIGN_EPI) { if (wr == 1) PG8_BAR; }
    }
    PG8_WAIT_V(0);
    if constexpr (!ALIGN_EPI) { if (wr == 0) PG8_BAR; }
    PG8_BAR;
    if constexpr (Epi::AFTER_DRAIN) { E.fused(acc, cur, wr, wc, fr, fq, lds, wid, lane); S.done(cur); }
#undef PG8_SA
#undef PG8_SB
#undef PG8_STAGE
#undef PG8_LDA
#undef PG8_LDB
#undef PG8_MMA
#undef PG8_WAIT_V
#undef PG8_WAIT_L
#undef PG8_BAR
#undef PG8_SCHED
}
}

constexpr int NWAVES = 8, NTHR = NWAVES * 64;
constexpr int DM = 1024, NBATCH = 8, SEQ = 4096, MROWS = NBATCH * SEQ;
constexpr int DFF = 4096, INW = 3864, INP = 4096, NMOD = 6 * DM;
constexpr float EPS = 1e-6f;
constexpr float QSCALE = 0.125f * 1.4426950408889634f;

typedef unsigned short bf16;
typedef unsigned u32x4 __attribute__((ext_vector_type(4)));
typedef float f32x4 __attribute__((ext_vector_type(4)));
typedef short bf16x8 __attribute__((ext_vector_type(8)));

constexpr size_t MiB = 1u << 20;
constexpr size_t WS_MOD = 1 * MiB;
constexpr size_t WS_CB = 1 * MiB + 512 * 1024;
constexpr size_t WS_COS = 2 * MiB, WS_SIN = 2 * MiB + 512 * 1024;
constexpr size_t WS_SELM = 3 * MiB;
constexpr size_t WS_KCC = 4 * MiB, WS_VCC = 5 * MiB;
constexpr size_t WS_WIN = 8 * MiB, WS_WA = 16 * MiB, WS_WB = 17 * MiB, WS_WOUT = 18 * MiB, WS_W1 = 20 * MiB, WS_W2 = 28 * MiB, WS_W1K = 36 * MiB, WS_W1V = 36 * MiB + 512 * 1024;
constexpr size_t WS_XN = 40 * MiB;
constexpr size_t WS_POOLED = 40 * MiB;
constexpr size_t WS_Y = 104 * MiB;
constexpr size_t WS_NG = 234 * MiB;
constexpr size_t WS_Q = 240 * MiB;
constexpr size_t WS_KV6 = 272 * MiB;
constexpr size_t WS_U = 320 * MiB;
constexpr size_t WS_BRG = 352 * MiB;
constexpr size_t WS_T1 = 272 * MiB;
constexpr size_t WS_HFF = 240 * MiB;
constexpr size_t WS_END = 496 * MiB;

constexpr int LDS_BYTES = 147456;

struct Args { const float* in[22]; float* out; unsigned char* ws; int ph_lo, ph_hi; };

#define LDS_WAIT() asm volatile("s_waitcnt lgkmcnt(0)" ::: "memory")
__device__ __forceinline__ unsigned f2bf(float f) { unsigned u = __float_as_uint(f); return (u + 0x7fffu + ((u >> 16) & 1u)) >> 16; }
__device__ __forceinline__ unsigned pk2(float lo, float hi) { return f2bf(lo) | (f2bf(hi) << 16); }
__device__ __forceinline__ float bf2f(bf16 h) { return __uint_as_float((unsigned)h << 16); }
__device__ __forceinline__ float bflo(unsigned w) { return __uint_as_float(w << 16); }
__device__ __forceinline__ float bfhi(unsigned w) { return __uint_as_float(w & 0xffff0000u); }
__device__ __forceinline__ float wave_sum(float v) {
#pragma unroll
    for (int o = 1; o < 64; o <<= 1) v += __shfl_xor(v, o);
    return v;
}
__device__ __forceinline__ float wave_max(float v) {
#pragma unroll
    for (int o = 1; o < 64; o <<= 1) v = fmaxf(v, __shfl_xor(v, o));
    return v;
}

__device__ __forceinline__ int win_dest(int c) {
    if (c < 1280) {
        const bool roped = (c < 640) || (c >= 768 && c < 896) || (c >= 1024 && c < 1152);
        if (!roped) return c;
        const int d = c & 63, base = c & ~63;
        return base + (d < 32 ? 2 * d : 2 * (d - 32) + 1);
    }
    if (c < 1304) return 3840 + (c - 1280);
    return c - 24;
}
__device__ __forceinline__ void transpose_item(const float* __restrict__ W, int K, int N, bf16* WT, int mode, float* scr, int item, int lane) {
    const int nblk = (N + 31) / 32, kb = item / nblk, nb = item % nblk, k0 = 64 * kb, n0 = 32 * nb;
    {
        const int n = n0 + (lane & 31);
#pragma unroll 8
        for (int i = 0; i < 32; ++i) { const int kk = 2 * i + (lane >> 5); scr[kk * 33 + (lane & 31)] = (n < N) ? W[(size_t)(k0 + kk) * N + n] : 0.f; }
    }
    LDS_WAIT();
    const int c = lane & 7;
#pragma unroll
    for (int j = 0; j < 4; ++j) {
        const int nl = (lane >> 3) + 8 * j, n = n0 + nl;
        float v[8];
#pragma unroll
        for (int e = 0; e < 8; ++e) { const int kk = (mode == 2) ? ((e & 1) * 32 + 4 * c + (e >> 1)) : (8 * c + e); v[e] = scr[kk * 33 + nl]; }
        if (n < N) {
            const int dr = (mode == 1) ? win_dest(n) : n;
            u32x4 o; o.x = pk2(v[0], v[1]); o.y = pk2(v[2], v[3]); o.z = pk2(v[4], v[5]); o.w = pk2(v[6], v[7]);
            *(u32x4*)(WT + (size_t)dr * K + k0 + 8 * c) = o;
        }
    }
    LDS_WAIT();
}

__device__ __forceinline__ void phase_p0(const Args& a, unsigned char* lds, int tid, int lane, int wave) {
    unsigned char* ws = a.ws;
    const int bid = blockIdx.x, G = gridDim.x;
    for (int job = bid; job < 98; job += G) {
        float* sl = (float*)lds; float* red = (float*)(lds + 32768);
        if (job < 96) {
            const float* c = a.in[1]; const float* w_ada = a.in[2]; const float* b_ada = a.in[3];
            for (int i = tid; i < 8192; i += NTHR) { const float v = c[i]; sl[i] = v / (1.f + __expf(-v)); }
            __syncthreads();
            const int j = job * 64 + lane, kb = wave * 128;
            float acc[8];
#pragma unroll
            for (int b = 0; b < 8; ++b) acc[b] = 0.f;
#pragma unroll 4
            for (int kk = 0; kk < 128; ++kk) { const int k = kb + kk; const float w = w_ada[(size_t)k * NMOD + j];
#pragma unroll
                for (int b = 0; b < 8; ++b) acc[b] += sl[b * 1024 + k] * w; }
#pragma unroll
            for (int b = 0; b < 8; ++b) red[(wave * 8 + b) * 64 + lane] = acc[b];
            __syncthreads();
            { const int b = wave; float s = 0.f;
#pragma unroll
              for (int w = 0; w < 8; ++w) s += red[(w * 8 + b) * 64 + lane];
              ((float*)(ws + WS_MOD))[b * NMOD + j] = s + b_ada[j]; }
            __syncthreads();
        } else {
            const int kv = job - 96; const float* pe = a.in[kv ? 10 : 7]; const float* w1 = a.in[kv ? 11 : 8];
            float acc = 0.f;
            for (int kk = wave * 256; kk < wave * 256 + 256; ++kk) acc += pe[kk] * w1[(size_t)kk * 64 + lane];
            red[wave * 64 + lane] = acc;
            __syncthreads();
            if (wave == 0) { float s = 0.f;
#pragma unroll
                for (int w = 0; w < 8; ++w) s += red[w * 64 + lane];
                ((float*)(ws + WS_CB))[kv * 64 + lane] = s; }
            __syncthreads();
        }
    }
    const int gw = bid * NWAVES + wave, NGW = G * NWAVES, gt = bid * NTHR + tid, NGT = G * NTHR;
    for (int e = gt; e < SEQ * 32; e += NGT) {
        const int t = e >> 5, i = e & 31;
        const float inv = powf(10000.0f, -(float)i / 32.0f);
        const float ang = (float)t * inv;
        const double ad = (double)ang;
        const double k = rint(ad * 0.15915494309189535);
        const float r = (float)(ad - k * 6.283185307179586);
        ((float*)(ws + WS_COS))[e] = cosf(r); ((float*)(ws + WS_SIN))[e] = sinf(r);
    }
    { u32x4 z = (u32x4){0u, 0u, 0u, 0u}; u32x4* p = (u32x4*)(ws + WS_WIN + (size_t)INW * DM * 2);
      for (int i = gt; i < (INP - INW) * DM * 2 / 16; i += NGT) p[i] = z;
      for (int i = gt; i < 2 * 16 * 8; i += NGT) { const int kv = i >> 7, bg = (i >> 3) & 15, ch = i & 7;
          *(u32x4*)(ws + (kv ? WS_VCC : WS_KCC) + ((size_t)(bg * 256 + 255) * 64 + ch * 8) * 2) = z; } }
    float* scr = (float*)(lds + wave * 16384);
    constexpr int I_IN = 16 * 121, I_A = 8 * 32, I_OUT = 16 * 32, I_1 = 16 * 128, I_2 = 64 * 32, I_CK = 32 * 2, I_CV = 32 * 2, I_WB = 1024;
    constexpr int NITEMS = I_IN + I_A + I_OUT + I_1 + I_2 + I_CK + I_CV + I_WB;
    for (int it = gw; it < NITEMS; it += NGW) {
        int r = it;
        if (r < I_IN) { transpose_item(a.in[6], 1024, INW, (bf16*)(ws + WS_WIN), 1, scr, r, lane); continue; } r -= I_IN;
        if (r < I_A) { transpose_item(a.in[15], 512, 1024, (bf16*)(ws + WS_WA), 0, scr, r, lane); continue; } r -= I_A;
        if (r < I_OUT) { transpose_item(a.in[17], 1024, 1024, (bf16*)(ws + WS_WOUT), 0, scr, r, lane); continue; } r -= I_OUT;
        if (r < I_1) { transpose_item(a.in[20], 1024, 4096, (bf16*)(ws + WS_W1), 0, scr, r, lane); continue; } r -= I_1;
        if (r < I_2) { transpose_item(a.in[21], 4096, 1024, (bf16*)(ws + WS_W2), 0, scr, r, lane); continue; } r -= I_2;
        if (r < I_CK) { transpose_item(a.in[8], 2048, 64, (bf16*)(ws + WS_W1K), 2, scr, r, lane); continue; } r -= I_CK;
        if (r < I_CV) { transpose_item(a.in[11], 2048, 64, (bf16*)(ws + WS_W1V), 0, scr, r, lane); continue; } r -= I_CV;
        {
            const float* w_pool = a.in[13]; const float* ps = a.in[14]; const float* wbr = a.in[16];
            const int kq = r >> 4, nb = r & 15, g = kq >> 4, c0 = (kq * 8) & 127, n = nb * 64 + lane;
            float acc[8];
#pragma unroll
            for (int e = 0; e < 8; ++e) acc[e] = 0.f;
            for (int d = 0; d < 128; ++d) {
                const float wb = wbr[(size_t)(g * 128 + d) * 1024 + n] * ps[g * 128 + d];
#pragma unroll
                for (int e = 0; e < 8; ++e) acc[e] += w_pool[(size_t)(g * 128 + c0 + e) * 128 + d] * wb;
            }
            u32x4 o; o.x = pk2(acc[0], acc[1]); o.y = pk2(acc[2], acc[3]); o.z = pk2(acc[4], acc[5]); o.w = pk2(acc[6], acc[7]);
            *(u32x4*)((bf16*)(ws + WS_WB) + (size_t)n * 512 + kq * 8) = o;
        }
    }
}

__device__ __forceinline__ void phase_norm_in(const Args& a, int lane, int wave) {
    const int gw = blockIdx.x * NWAVES + wave, NGW = gridDim.x * NWAVES;
    const float* x = a.in[0]; const float* g = a.in[4]; const float* mod = (const float*)(a.ws + WS_MOD); bf16* XN = (bf16*)(a.ws + WS_XN);
    for (int m = gw; m < MROWS; m += NGW) {
        const int b = m >> 12;
        const f32x4* xr = (const f32x4*)(x + (size_t)m * DM) + lane;
        f32x4 v[4]; float s = 0.f;
#pragma unroll
        for (int j = 0; j < 4; ++j) { v[j] = xr[64 * j]; s += (v[j].x * v[j].x + v[j].y * v[j].y) + (v[j].z * v[j].z + v[j].w * v[j].w); }
        const float rstd = rsqrtf(wave_sum(s) * (1.f / DM) + EPS);
        unsigned long long* o8 = (unsigned long long*)(XN + (size_t)m * DM) + lane;
#pragma unroll
        for (int j = 0; j < 4; ++j) {
            const int c = 4 * lane + 256 * j;
            const f32x4 gg = *(const f32x4*)(g + c), sh = *(const f32x4*)(mod + b * NMOD + c), sc = *(const f32x4*)(mod + b * NMOD + DM + c);
            const f32x4 h = v[j] * rstd * gg * (sc + 1.0f) + sh;
            o8[64 * j] = (unsigned long long)pk2(h.x, h.y) | ((unsigned long long)pk2(h.z, h.w) << 32);
        }
    }
}

__device__ __forceinline__ float gelu_tanh(float x) {
    const float z = 0.7978845608028654f * (x + 0.044715f * x * x * x);
    const float e = __expf(2.f * z);
    const float th = 1.f - 2.f / (e + 1.f);
    return 0.5f * x * (1.f + th);
}
__device__ __forceinline__ void phase_compress_pool(const Args& a, unsigned char* lds, int tid, int lane, int wave) {
    unsigned char* ws = a.ws;
    const int gw = blockIdx.x * NWAVES + wave, NGW = gridDim.x * NWAVES;
    const bf16* KV6 = (const bf16*)(ws + WS_KV6);
    float* hbuf = (float*)(lds + wave * 4096);
    for (int job = gw; job < 512; job += NGW) {
        const int nt = job & 15, g = (job >> 4) & 1, b = (job >> 5) & 7, kv = job >> 8;
        const bf16* W1T = (const bf16*)(ws + (kv ? WS_W1V : WS_W1K));
        const float* w2 = a.in[kv ? 12 : 9]; const float* cb = (const float*)(ws + WS_CB) + kv * 64;
        const int fr = lane & 15, fq = lane >> 4;
        const bf16* Ab = KV6 + (size_t)(b * SEQ + 16 * (nt * 16 + fr)) * 768 + kv * 128 + g * 64 + 8 * fq;
        const bf16* Bb = W1T + (size_t)fr * 2048 + 8 * fq;
        f32x4 acc[4];
#pragma unroll
        for (int nn = 0; nn < 4; ++nn) acc[nn] = (f32x4){0.f, 0.f, 0.f, 0.f};
#pragma unroll 4
        for (int kk = 0; kk < 64; ++kk) {
            const bf16x8 af = *(const bf16x8*)(Ab + (size_t)(kk >> 1) * 768 + (kk & 1) * 32);
#pragma unroll
            for (int nn = 0; nn < 4; ++nn) {
                const bf16x8 bfr = *(const bf16x8*)(Bb + (size_t)nn * 16 * 2048 + kk * 32);
                acc[nn] = __builtin_amdgcn_mfma_f32_16x16x32_bf16(af, bfr, acc[nn], 0, 0, 0);
            }
        }
#pragma unroll
        for (int nn = 0; nn < 4; ++nn) { const int col = nn * 16 + fr; const float bias = cb[col];
#pragma unroll
            for (int r = 0; r < 4; ++r) hbuf[(fq * 4 + r) * 64 + col] = gelu_tanh(acc[nn][r] + bias); }
        LDS_WAIT();
        float w2c[64];
#pragma unroll
        for (int k = 0; k < 64; ++k) w2c[k] = w2[k * 64 + lane];
        bf16* OUT = (bf16*)(ws + (kv ? WS_VCC : WS_KCC)) + (size_t)((b * 2 + g) * 256) * 64;
        const int ocol = kv ? lane : ((lane < 32) ? 2 * lane : 2 * (lane - 32) + 1);
        for (int r = 0; r < 16; ++r) {
            float s = 0.f;
#pragma unroll
            for (int k = 0; k < 64; ++k) s += hbuf[r * 64 + k] * w2c[k];
            const int n = nt * 16 + r;
            if (n < 255) OUT[(size_t)n * 64 + ocol] = (bf16)f2bf(s);
        }
        LDS_WAIT();
    }
    const bf16* U = (const bf16*)(ws + WS_U); bf16* P = (bf16*)(ws + WS_POOLED);
    const int gt = blockIdx.x * NTHR + tid, NGT = gridDim.x * NTHR;
    for (int idx = gt; idx < MROWS * 64; idx += NGT) {
        const int row = idx >> 6, c8 = idx & 63, t = row & (SEQ - 1), w = 2 << (c8 >> 4), cnt = (t + 1 < w) ? (t + 1) : w;
        float s[8], u0[8];
#pragma unroll
        for (int e = 0; e < 8; ++e) s[e] = 0.f;
        for (int j = 0; j < cnt; ++j) {
            const u32x4 q = *(const u32x4*)(U + (size_t)(row - j) * 512 + c8 * 8);
            const float f[8] = {bflo(q.x), bfhi(q.x), bflo(q.y), bfhi(q.y), bflo(q.z), bfhi(q.z), bflo(q.w), bfhi(q.w)};
#pragma unroll
            for (int e = 0; e < 8; ++e) { s[e] += f[e]; if (j == 0) u0[e] = f[e]; }
        }
        const float ic = 1.f / (float)cnt;
        u32x4 o; o.x = pk2(s[0] * ic - u0[0], s[1] * ic - u0[1]); o.y = pk2(s[2] * ic - u0[2], s[3] * ic - u0[3]);
        o.z = pk2(s[4] * ic - u0[4], s[5] * ic - u0[5]); o.w = pk2(s[6] * ic - u0[6], s[7] * ic - u0[7]);
        *(u32x4*)(P + (size_t)row * 512 + c8 * 8) = o;
    }
}

__device__ __forceinline__ void load_q64(float (&qf)[64], const bf16* q) {
#pragma unroll
    for (int c = 0; c < 8; ++c) { const u32x4 w = *(const u32x4*)(q + 8 * c);
        qf[8 * c + 0] = bflo(w.x); qf[8 * c + 1] = bfhi(w.x); qf[8 * c + 2] = bflo(w.y); qf[8 * c + 3] = bfhi(w.y);
        qf[8 * c + 4] = bflo(w.z); qf[8 * c + 5] = bfhi(w.z); qf[8 * c + 6] = bflo(w.w); qf[8 * c + 7] = bfhi(w.w); }
}
__device__ __forceinline__ float dot64(const float (&qf)[64], const bf16* k) {
    float s0 = 0.f, s1 = 0.f;
#pragma unroll
    for (int c = 0; c < 8; ++c) { const u32x4 w = *(const u32x4*)(k + 8 * c);
        s0 += qf[8 * c + 0] * bflo(w.x) + qf[8 * c + 2] * bflo(w.y) + qf[8 * c + 4] * bflo(w.z) + qf[8 * c + 6] * bflo(w.w);
        s1 += qf[8 * c + 1] * bfhi(w.x) + qf[8 * c + 3] * bfhi(w.y) + qf[8 * c + 5] * bfhi(w.z) + qf[8 * c + 7] * bfhi(w.w); }
    return s0 + s1;
}
__device__ __forceinline__ void phase_nsa_ref(const Args& a, unsigned char* lds, int lane, int wave) {
    unsigned char* ws = a.ws;
    const int gw = blockIdx.x * NWAVES + wave, NGW = gridDim.x * NWAVES;
    const bf16* Q = (const bf16*)(ws + WS_Q); const bf16* KV6 = (const bf16*)(ws + WS_KV6); const float* NG = (const float*)(ws + WS_NG);
    bf16* O = (bf16*)(ws + WS_Q);
    unsigned long long* SELM = (unsigned long long*)(ws + WS_SELM);
    float* pc = (float*)(lds + wave * 8192);
    float* pb = (float*)(lds + wave * 8192 + 4096);
    for (int task = gw; task < NBATCH * 2 * SEQ; task += NGW) {
        const int t = task & (SEQ - 1), g = (task >> 12) & 1, b = task >> 13;
        const size_t row = (size_t)b * SEQ + t;
        const bf16* Kc = (const bf16*)(ws + WS_KCC) + (size_t)((b * 2 + g) * 256) * 64;
        const bf16* Vc = (const bf16*)(ws + WS_VCC) + (size_t)((b * 2 + g) * 256) * 64;
        const int nvis = (t >= 31) ? (((t - 31) >> 4) + 1) : 0;
        float qf[64]; float oacc[4];
#pragma unroll
        for (int r = 0; r < 4; ++r) {
            const int h = g * 4 + r;
            load_q64(qf, Q + row * 512 + h * 64);
            float s[4]; float mx = -INFINITY;
#pragma unroll
            for (int i = 0; i < 4; ++i) { const int n = lane + 64 * i; s[i] = (n < nvis) ? dot64(qf, Kc + (size_t)n * 64) : -INFINITY; mx = fmaxf(mx, s[i]); }
            mx = wave_max(mx); if (nvis == 0) mx = 0.f;
            float z = 0.f;
#pragma unroll
            for (int i = 0; i < 4; ++i) { s[i] = (lane + 64 * i < nvis) ? exp2f(s[i] - mx) : 0.f; z += s[i]; }
            z = wave_sum(z); const float inv = (nvis > 0) ? 1.f / z : 0.f;
#pragma unroll
            for (int i = 0; i < 4; ++i) pc[r * 256 + lane + 64 * i] = s[i] * inv;
            LDS_WAIT();
            float o = 0.f;
            for (int n = 0; n < nvis; ++n) o += pc[r * 256 + n] * bf2f(Vc[(size_t)n * 64 + lane]);
            oacc[r] = NG[row * 24 + h * 3 + 0] * o;
        }
        float imp = 0.f;
#pragma unroll
        for (int r = 0; r < 4; ++r)
#pragma unroll
            for (int dn = -1; dn <= 3; ++dn) { const int n = 4 * lane + dn; if (n >= 0 && n < nvis) imp += pc[r * 256 + n]; }
        const int cur = t >> 6;
        const bool causal = lane <= cur, forced = (lane == 0) || (causal && lane > cur - 2);
        const float val = forced ? 1e9f : (causal ? imp : -INFINITY);
        int rank = 0;
        for (int j = 0; j < 64; ++j) { const float vj = __shfl(val, j); rank += ((vj > val) || (vj == val && j < lane)) ? 1 : 0; }
        const unsigned long long mask = __ballot((rank < 16) && causal);
        if (lane == 0) SELM[(size_t)(b * 2 + g) * SEQ + t] = mask;
#pragma unroll
        for (int r = 0; r < 4; ++r) {
            const int h = g * 4 + r;
            load_q64(qf, Q + row * 512 + h * 64);
            {
                const bf16* Ks = KV6 + (size_t)b * SEQ * 768 + 256 + g * 64; const bf16* Vs = KV6 + (size_t)b * SEQ * 768 + 384 + g * 64;
                float mx = -INFINITY;
                for (unsigned long long mm = mask; mm; mm &= mm - 1) { const int blk = __builtin_ctzll(mm), key = blk * 64 + lane;
                    if (key <= t) mx = fmaxf(mx, dot64(qf, Ks + (size_t)key * 768)); }
                mx = wave_max(mx);
                float z = 0.f, o = 0.f;
                for (unsigned long long mm = mask; mm; mm &= mm - 1) { const int blk = __builtin_ctzll(mm), key = blk * 64 + lane;
                    const float e = (key <= t) ? exp2f(dot64(qf, Ks + (size_t)key * 768) - mx) : 0.f;
                    z += e; pb[lane] = e; LDS_WAIT();
                    for (int j = 0; j < 64; ++j) o += pb[j] * bf2f(Vs[(size_t)(blk * 64 + j) * 768 + lane]);
                    LDS_WAIT(); }
                z = wave_sum(z);
                oacc[r] += NG[row * 24 + h * 3 + 1] * o / z;
            }
            {
                const bf16* Kw = KV6 + (size_t)b * SEQ * 768 + 512 + g * 64; const bf16* Vw = KV6 + (size_t)b * SEQ * 768 + 640 + g * 64;
                const int k0 = t - 511;
                float mx = -INFINITY;
                for (int c = 0; c < 8; ++c) { const int key = k0 + 64 * c + lane; if (key >= 0) mx = fmaxf(mx, dot64(qf, Kw + (size_t)key * 768)); }
                mx = wave_max(mx);
                float z = 0.f, o = 0.f;
                for (int c = 0; c < 8; ++c) { const int key = k0 + 64 * c + lane;
                    const float e = (key >= 0) ? exp2f(dot64(qf, Kw + (size_t)key * 768) - mx) : 0.f;
                    z += e; pb[lane] = e; LDS_WAIT();
                    const int kb = k0 + 64 * c;
                    for (int j = 0; j < 64; ++j) { const int kj = (kb + j) < 0 ? 0 : (kb + j); o += pb[j] * bf2f(Vw[(size_t)kj * 768 + lane]); }
                    LDS_WAIT(); }
                z = wave_sum(z);
                oacc[r] += NG[row * 24 + h * 3 + 2] * o / z;
            }
        }
#pragma unroll
        for (int r = 0; r < 4; ++r) O[row * 512 + (g * 4 + r) * 64 + lane] = (bf16)f2bf(oacc[r]);
    }
}

__device__ __forceinline__ void phase_mid_norm(const Args& a, int lane, int wave) {
    const int gw = blockIdx.x * NWAVES + wave, NGW = gridDim.x * NWAVES;
    const float* x = a.in[0]; const float* gpost = a.in[5]; const float* gpre = a.in[18];
    const float* mod = (const float*)(a.ws + WS_MOD); const float* Y = (const float*)(a.ws + WS_Y); bf16* XN = (bf16*)(a.ws + WS_XN);
    for (int m = gw; m < MROWS; m += NGW) {
        const int b = m >> 12; const float* mb = mod + b * NMOD;
        const f32x4* yr = (const f32x4*)(Y + (size_t)m * DM) + lane; const f32x4* xr = (const f32x4*)(x + (size_t)m * DM) + lane;
        f32x4 v[4]; float s = 0.f;
#pragma unroll
        for (int j = 0; j < 4; ++j) { v[j] = yr[64 * j]; s += (v[j].x * v[j].x + v[j].y * v[j].y) + (v[j].z * v[j].z + v[j].w * v[j].w); }
        const float rstd = rsqrtf(wave_sum(s) * (1.f / DM) + EPS);
        float s2 = 0.f;
#pragma unroll
        for (int j = 0; j < 4; ++j) { const int c = 4 * lane + 256 * j;
            const f32x4 gg = *(const f32x4*)(gpost + c), gt = *(const f32x4*)(mb + 2 * DM + c);
            v[j] = xr[64 * j] + gt * (v[j] * rstd * gg);
            s2 += (v[j].x * v[j].x + v[j].y * v[j].y) + (v[j].z * v[j].z + v[j].w * v[j].w); }
        const float rstd2 = rsqrtf(wave_sum(s2) * (1.f / DM) + EPS);
        f32x4* orow = (f32x4*)(a.out + (size_t)m * DM) + lane;
        unsigned long long* o8 = (unsigned long long*)(XN + (size_t)m * DM) + lane;
#pragma unroll
        for (int j = 0; j < 4; ++j) { const int c = 4 * lane + 256 * j;
            orow[64 * j] = v[j];
            const f32x4 gg = *(const f32x4*)(gpre + c), sh = *(const f32x4*)(mb + 3 * DM + c), sc = *(const f32x4*)(mb + 4 * DM + c);
            const f32x4 h = v[j] * rstd2 * gg * (sc + 1.0f) + sh;
            o8[64 * j] = (unsigned long long)pk2(h.x, h.y) | ((unsigned long long)pk2(h.z, h.w) << 32); }
    }
}
__device__ __forceinline__ void phase_final_norm(const Args& a, int lane, int wave) {
    const int gw = blockIdx.x * NWAVES + wave, NGW = gridDim.x * NWAVES;
    const float* gpost = a.in[19]; const float* mod = (const float*)(a.ws + WS_MOD); const float* Y = (const float*)(a.ws + WS_Y);
    for (int m = gw; m < MROWS; m += NGW) {
        const int b = m >> 12; const float* mb = mod + b * NMOD;
        const f32x4* yr = (const f32x4*)(Y + (size_t)m * DM) + lane; f32x4* orow = (f32x4*)(a.out + (size_t)m * DM) + lane;
        f32x4 v[4]; float s = 0.f;
#pragma unroll
        for (int j = 0; j < 4; ++j) { v[j] = yr[64 * j]; s += (v[j].x * v[j].x + v[j].y * v[j].y) + (v[j].z * v[j].z + v[j].w * v[j].w); }
        const float rstd = rsqrtf(wave_sum(s) * (1.f / DM) + EPS);
#pragma unroll
        for (int j = 0; j < 4; ++j) { const int c = 4 * lane + 256 * j;
            const f32x4 gg = *(const f32x4*)(gpost + c), gt = *(const f32x4*)(mb + 5 * DM + c);
            orow[64 * j] = orow[64 * j] + gt * (v[j] * rstd * gg); }
    }
}

constexpr int N_PHASES = 12;
__global__ void __launch_bounds__(NTHR, 2) fwd_kernel(Args a) {
    extern __shared__ __attribute__((aligned(16))) unsigned char lds[];
    cg::grid_group grid = cg::this_grid();
    const int tid = threadIdx.x, lane = tid & 63, wave = __builtin_amdgcn_readfirstlane(tid >> 6);
    unsigned char* ws = a.ws;
    const int lo = a.ph_lo, hi = a.ph_hi, G = gridDim.x, bid = blockIdx.x;
    PG8_LAS unsigned char* ldsg = (PG8_LAS unsigned char*)lds;
#define IN(k) (lo <= (k) && (k) < hi)
#define SEAM(k) do { if ((k) + 1 < hi) grid.sync(); } while (0)
    if (IN(0)) { phase_p0(a, lds, tid, lane, wave); SEAM(0); }
    if (IN(1)) { phase_norm_in(a, lane, wave); SEAM(1); }
    if (IN(2)) {
        pg8::Gemm g{(const bf16*)(ws + WS_XN), (const bf16*)(ws + WS_WIN), MROWS, INP, DM}; pg8::StaticOrder S; S.init(MROWS, INP, G, bid);
        pg8::EpiProj E{(bf16*)(ws + WS_Q), (bf16*)(ws + WS_KV6), (bf16*)(ws + WS_U), (bf16*)(ws + WS_BRG), (float*)(ws + WS_NG), (const float*)(ws + WS_COS), (const float*)(ws + WS_SIN), QSCALE};
        pg8::gemm_phase<pg8::EpiProj, pg8::StaticOrder, true, true>(ldsg, g, S, E);
        SEAM(2);
    }
    if (IN(3)) { phase_compress_pool(a, lds, tid, lane, wave); SEAM(3); }
    if (IN(4)) { phase_nsa_ref(a, lds, lane, wave); SEAM(4); }
    if (IN(5)) {
        pg8::Gemm g{(const bf16*)(ws + WS_Q), (const bf16*)(ws + WS_WA), MROWS, DM, 512}; pg8::StaticOrder S; S.init(MROWS, DM, G, bid);
        pg8::EpiGate<0> E{(bf16*)(ws + WS_T1), (const bf16*)(ws + WS_BRG)};
        pg8::gemm_phase<pg8::EpiGate<0>, pg8::StaticOrder, true, true>(ldsg, g, S, E);
        SEAM(5);
    }
    if (IN(6)) {
        pg8::Gemm g{(const bf16*)(ws + WS_POOLED), (const bf16*)(ws + WS_WB), MROWS, DM, 512}; pg8::StaticOrder S; S.init(MROWS, DM, G, bid);
        pg8::EpiGate<1> E{(bf16*)(ws + WS_T1), (const bf16*)(ws + WS_BRG) + 1024};
        pg8::gemm_phase<pg8::EpiGate<1>, pg8::StaticOrder, true, true>(ldsg, g, S, E);
        SEAM(6);
    }
    if (IN(7)) {
        pg8::Gemm g{(const bf16*)(ws + WS_T1), (const bf16*)(ws + WS_WOUT), MROWS, DM, DM}; pg8::StaticOrder S; S.init(MROWS, DM, G, bid);
        pg8::EpiF32 E{(float*)(ws + WS_Y), DM};
        pg8::gemm_phase<pg8::EpiF32, pg8::StaticOrder, true, true>(ldsg, g, S, E);
        SEAM(7);
    }
    if (IN(8)) { phase_mid_norm(a, lane, wave); SEAM(8); }
    if (IN(9)) {
        pg8::Gemm g{(const bf16*)(ws + WS_XN), (const bf16*)(ws + WS_W1), MROWS, DFF, DM}; pg8::StaticOrder S; S.init(MROWS, DFF, G, bid);
        pg8::EpiRelu2 E{(bf16*)(ws + WS_HFF), DFF};
        pg8::gemm_phase<pg8::EpiRelu2, pg8::StaticOrder, true, true>(ldsg, g, S, E);
        SEAM(9);
    }
    if (IN(10)) {
        pg8::Gemm g{(const bf16*)(ws + WS_HFF), (const bf16*)(ws + WS_W2), MROWS, DM, DFF}; pg8::StaticOrder S; S.init(MROWS, DM, G, bid);
        pg8::EpiF32 E{(float*)(ws + WS_Y), DM};
        pg8::gemm_phase<pg8::EpiF32, pg8::StaticOrder, true, true>(ldsg, g, S, E);
        SEAM(10);
    }
    if (IN(11)) { phase_final_norm(a, lane, wave); }
#undef IN
#undef SEAM
}

extern "C" void kernel_launch(void* const* d_in, const int* in_sizes, int n_in, void* d_out, int out_size, void* d_ws, size_t ws_size, hipStream_t stream) {
    static int grid = 0;
    if (grid == 0) {
        if (n_in != 22 || in_sizes[0] != MROWS * DM || out_size != MROWS * DM || ws_size < WS_END) {
            fprintf(stderr, "kernel_launch: unexpected shapes (n_in %d, in0 %d, out %d, ws %zu); nothing launched\n", n_in, n_in > 0 ? in_sizes[0] : -1, out_size, ws_size); grid = -1; return; }
        int dev = 0, cus = 0, per_cu = 0;
        if (hipGetDevice(&dev) != hipSuccess || hipDeviceGetAttribute(&cus, hipDeviceAttributeMultiprocessorCount, dev) != hipSuccess) { grid = -1; return; }
        if (hipFuncSetAttribute((const void*)fwd_kernel, hipFuncAttributeMaxDynamicSharedMemorySize, LDS_BYTES) != hipSuccess) { fprintf(stderr, "kernel_launch: hipFuncSetAttribute failed\n"); grid = -1; return; }
        if (hipOccupancyMaxActiveBlocksPerMultiprocessor(&per_cu, (const void*)fwd_kernel, NTHR, LDS_BYTES) != hipSuccess || per_cu < 1) { fprintf(stderr, "kernel_launch: occupancy query says %d blocks per CU\n", per_cu); grid = -1; (void)hipGetLastError(); return; }
        grid = cus;
    }
    if (grid < 0) return;
    Args a{};
    for (int i = 0; i < 22; ++i) a.in[i] = (const float*)d_in[i];
    a.out = (float*)d_out; a.ws = (unsigned char*)d_ws;
    constexpr int NL = MK_N_LAUNCHES;
    for (int li = 0; li < NL; ++li) {
        a.ph_lo = (NL == 1) ? 0 : li; a.ph_hi = (NL == 1) ? N_PHASES : li + 1;
        void* args[] = {&a};
        const hipError_t e = hipLaunchCooperativeKernel((const void*)fwd_kernel, dim3(grid), dim3(NTHR), args, LDS_BYTES, stream);
        if (e != hipSuccess) { fprintf(stderr, "kernel_launch: cooperative launch %d failed: %s (grid %d)\n", li, hipGetErrorString(e), grid); break; }
    }
}
```

```cpp
#include <hip/hip_runtime.h>
#include <hip/hip_cooperative_groups.h>
#include <cstdio>
#include <cstdint>
namespace cg = cooperative_groups;

#ifndef MK_N_LAUNCHES
#define MK_N_LAUNCHES 1
#endif

namespace pg8 {
#define PG8_LAS __attribute__((address_space(3)))
typedef unsigned short bf16_t;
typedef short bf16x8 __attribute__((ext_vector_type(8)));
typedef float f32x4 __attribute__((ext_vector_type(4)));
typedef unsigned u32x4 __attribute__((ext_vector_type(4)));
constexpr int BM = 256, BK = 64, HALF = 128, HTB = HALF * BK * 2  , STAGE_BYTES = 8 * HTB, NXCD = 8, WGM = 8;

__host__ __device__ __forceinline__ int lds_byte(int r, int c) { const int st = (r >> 4) * 2 + (c >> 5), rr = r & 15, cc = c & 31, ob = rr * 64 + cc * 2; return st * 1024 + (ob ^ (((ob >> 9) & 1) << 5)); }
__host__ __device__ __forceinline__ void stage_rc(int b, int& R, int& C) { const int st = b / 1024, sb = b % 1024, swz = sb ^ (((sb >> 9) & 1) << 5); R = (st >> 1) * 16 + swz / 64; C = (st & 1) * 32 + (swz % 64) / 2; }
__host__ __device__ __forceinline__ int perm32(int rho) { const int n = rho >> 4, i = rho & 15; return 8 * (i >> 2) + 4 * n + (i & 3); }

struct Unit { int pm, pn; };
struct Gemm { const bf16_t* A; const bf16_t* Bt; int M, N, K; };

struct StaticOrder {
    int nM, nN, nwg, G, c;
    __host__ __device__ void init(int M, int N, int G_, int c_) { nM = M / BM; nN = N / BM; nwg = nM * nN; G = G_; c = c_; }
    __host__ __device__ bool next(int i, Unit& u) const {
        const long L = (long)i * G + c; if (L >= nwg) return false;
        int wgid = (int)L; { const int q = nwg / NXCD, r = nwg % NXCD, xcd = wgid % NXCD, off = wgid / NXCD; wgid = (xcd < r ? xcd * (q + 1) : r * (q + 1) + (xcd - r) * q) + off; }
        const int nig = WGM * nN, gid = wgid / nig, fm = gid * WGM, gsz = (nM - fm) < WGM ? (nM - fm) : WGM;
        u.pm = fm + ((wgid % nig) % gsz); u.pn = (wgid % nig) / gsz; return true;
    }
    __device__ __forceinline__ void a_ready(const Unit&) const {}
    __device__ __forceinline__ void done(const Unit&) const {}
};

__device__ __forceinline__ unsigned cvt_pk_bf16(float lo, float hi) { unsigned r; asm volatile("v_cvt_pk_bf16_f32 %0, %1, %2" : "=v"(r) : "v"(lo), "v"(hi)); return r; }
__device__ __forceinline__ float bflo(unsigned w) { return __uint_as_float(w << 16); }
__device__ __forceinline__ float bfhi(unsigned w) { return __uint_as_float(w & 0xffff0000u); }
__device__ __forceinline__ float sigm(float x) { return 1.f / (1.f + __expf(-x)); }
__device__ __forceinline__ u32x4 pack8(const f32x4& a, const f32x4& b) { u32x4 w; w.x = cvt_pk_bf16(a[0], a[1]); w.y = cvt_pk_bf16(a[2], a[3]); w.z = cvt_pk_bf16(b[0], b[1]); w.w = cvt_pk_bf16(b[2], b[3]); return w; }

struct EpiProj {
    static constexpr bool PERM = true, AFTER_DRAIN = false;
    bf16_t *Q, *KV6, *U, *BRG; float* NG; const float *COS, *SIN; float qscale;
    __device__ __forceinline__ void operator()(const f32x4 (&acc)[2][2][4][2], const Unit& u, int wr, int wc, int fr, int fq) const {
        const int row0 = u.pm * BM + wr * 64 + fr, pn = u.pn, cl = wc * 32 + 8 * fq, i0 = (cl & 63) >> 1;
#pragma unroll
        for (int ai = 0; ai < 2; ++ai)
#pragma unroll
            for (int m = 0; m < 4; ++m) {
                const int row = row0 + ai * HALF + m * 16, t = row & 4095;
                f32x4 cs = (f32x4){1.f, 1.f, 1.f, 1.f}, sn = (f32x4){0.f, 0.f, 0.f, 0.f};
                if (pn < 5) { cs = *(const f32x4*)(COS + t * 32 + i0); sn = *(const f32x4*)(SIN + t * 32 + i0); }
#pragma unroll
                for (int bj = 0; bj < 2; ++bj) {
                    f32x4 v0 = acc[ai][bj][m][0], v1 = acc[ai][bj][m][1];
                    const int col = bj * HALF + cl;
                    if (pn < 2 || (pn < 5 && bj == 0)) {
                        f32x4 r0, r1;
                        r0[0] = v0[0] * cs[0] - v0[1] * sn[0]; r0[1] = v0[1] * cs[0] + v0[0] * sn[0];
                        r0[2] = v0[2] * cs[1] - v0[3] * sn[1]; r0[3] = v0[3] * cs[1] + v0[2] * sn[1];
                        r1[0] = v1[0] * cs[2] - v1[1] * sn[2]; r1[1] = v1[1] * cs[2] + v1[0] * sn[2];
                        r1[2] = v1[2] * cs[3] - v1[3] * sn[3]; r1[3] = v1[3] * cs[3] + v1[2] * sn[3];
                        v0 = r0; v1 = r1;
                    }
                    if (pn < 2) { v0 = v0 * qscale; v1 = v1 * qscale; *(u32x4*)(Q + (size_t)row * 512 + pn * 256 + col) = pack8(v0, v1); }
                    else if (pn < 5) { *(u32x4*)(KV6 + (size_t)row * 768 + (pn - 2) * 256 + col) = pack8(v0, v1); }
                    else if (pn < 7) { *(u32x4*)(U + (size_t)row * 512 + (pn - 5) * 256 + col) = pack8(v0, v1); }
                    else if (pn < 15) {
#pragma unroll
                        for (int j = 0; j < 4; ++j) { v0[j] = sigm(v0[j]); v1[j] = sigm(v1[j]); }
                        *(u32x4*)(BRG + (size_t)row * 2048 + (pn - 7) * 256 + col) = pack8(v0, v1);
                    } else if (bj == 0 && cl < 24) {
#pragma unroll
                        for (int j = 0; j < 4; ++j) { v0[j] = sigm(v0[j]); v1[j] = sigm(v1[j]); }
                        *(f32x4*)(NG + (size_t)row * 24 + cl) = v0; *(f32x4*)(NG + (size_t)row * 24 + cl + 4) = v1;
                    }
                }
            }
    }
};
template <int MODE> struct EpiGate {
    static constexpr bool PERM = true, AFTER_DRAIN = false;
    bf16_t* T; const bf16_t* G;
    __device__ __forceinline__ void operator()(const f32x4 (&acc)[2][2][4][2], const Unit& u, int wr, int wc, int fr, int fq) const {
        const int row0 = u.pm * BM + wr * 64 + fr, cl = u.pn * BM + wc * 32 + 8 * fq;
#pragma unroll
        for (int ai = 0; ai < 2; ++ai)
#pragma unroll
            for (int m = 0; m < 4; ++m) {
                const int row = row0 + ai * HALF + m * 16;
#pragma unroll
                for (int bj = 0; bj < 2; ++bj) {
                    const int col = bj * HALF + cl;
                    const u32x4 g = *(const u32x4*)(G + (size_t)row * 2048 + col);
                    f32x4 v0 = acc[ai][bj][m][0], v1 = acc[ai][bj][m][1];
                    v0[0] *= bflo(g.x); v0[1] *= bfhi(g.x); v0[2] *= bflo(g.y); v0[3] *= bfhi(g.y);
                    v1[0] *= bflo(g.z); v1[1] *= bfhi(g.z); v1[2] *= bflo(g.w); v1[3] *= bfhi(g.w);
                    if (MODE == 1) {
                        const u32x4 p = *(const u32x4*)(T + (size_t)row * 1024 + col);
                        v0[0] += bflo(p.x); v0[1] += bfhi(p.x); v0[2] += bflo(p.y); v0[3] += bfhi(p.y);
                        v1[0] += bflo(p.z); v1[1] += bfhi(p.z); v1[2] += bflo(p.w); v1[3] += bfhi(p.w);
                    }
                    *(u32x4*)(T + (size_t)row * 1024 + col) = pack8(v0, v1);
                }
            }
    }
};
struct EpiF32 {
    static constexpr bool PERM = false, AFTER_DRAIN = false;
    float* C; int ldc;
    __device__ __forceinline__ void operator()(const f32x4 (&acc)[2][2][4][2], const Unit& u, int wr, int wc, int fr, int fq) const {
        const int row0 = u.pm * BM + wr * 64 + fr, col0 = u.pn * BM + wc * 32 + 4 * fq;
#pragma unroll
        for (int ai = 0; ai < 2; ++ai)
#pragma unroll
            for (int m = 0; m < 4; ++m) { float* rowp = C + (size_t)(row0 + ai * HALF + m * 16) * ldc + col0;
#pragma unroll
                for (int bj = 0; bj < 2; ++bj)
#pragma unroll
                    for (int n = 0; n < 2; ++n) *(f32x4*)(rowp + bj * HALF + n * 16) = acc[ai][bj][m][n]; }
    }
};
struct EpiRelu2 {
    static constexpr bool PERM = true, AFTER_DRAIN = false;
    bf16_t* H; int ldc;
    __device__ __forceinline__ void operator()(const f32x4 (&acc)[2][2][4][2], const Unit& u, int wr, int wc, int fr, int fq) const {
        const int row0 = u.pm * BM + wr * 64 + fr, col0 = u.pn * BM + wc * 32 + 8 * fq;
#pragma unroll
        for (int ai = 0; ai < 2; ++ai)
#pragma unroll
            for (int m = 0; m < 4; ++m) { bf16_t* rowp = H + (size_t)(row0 + ai * HALF + m * 16) * ldc + col0;
#pragma unroll
                for (int bj = 0; bj < 2; ++bj) { f32x4 v0 = acc[ai][bj][m][0], v1 = acc[ai][bj][m][1];
#pragma unroll
                    for (int j = 0; j < 4; ++j) { const float a = fmaxf(v0[j], 0.f), b = fmaxf(v1[j], 0.f); v0[j] = a * a; v1[j] = b * b; }
                    *(u32x4*)(rowp + bj * HALF) = pack8(v0, v1); } }
    }
};

template <class Epi, class Sched, bool ALIGN_EPI = false, bool SP2 = false>
__device__ __forceinline__ void gemm_phase(PG8_LAS unsigned char* lds, const Gemm g, const Sched& S, const Epi& E) {
    const int tid = threadIdx.x, wid = __builtin_amdgcn_readfirstlane(tid >> 6), lane = tid & 63, wr = wid >> 2, wc = wid & 3, fr = lane & 15, fq = lane >> 4;
    const int K = g.K, nt = K / BK;
    unsigned voffA[2], voffB[2];
#pragma unroll
    for (int i = 0; i < 2; ++i) { int R, C; stage_rc(tid * 16 + i * 8192, R, C); const int Rb = Epi::PERM ? ((R & ~31) + perm32(R & 31)) : R;
        voffA[i] = (unsigned)(R * K + C) * 2u; voffB[i] = (unsigned)(Rb * K + C) * 2u; }
    const size_t kstep = (size_t)(BK * 2);
    const size_t hstep = (size_t)HALF * K * 2;
    const size_t tstep = 2 * hstep;
    const unsigned ldsw = (unsigned)wid * 1024u;
    const int aoff = lds_byte(wr * 64 + fr, fq * 8), boff = lds_byte(wc * 32 + fr, fq * 8);
#define PG8_SA(b, h) (((b) * 2 + (h)) * HTB)
#define PG8_SB(b, h) ((4 + (b) * 2 + (h)) * HTB)
#define PG8_STAGE(bufoff, gbase, voff) do { _Pragma("unroll") for (int _i = 0; _i < 2; ++_i) \
        __builtin_amdgcn_global_load_lds((const unsigned*)((const char*)(gbase) + (voff)[_i]), (PG8_LAS unsigned*)(lds + (bufoff) + ldsw + _i * 8192), 16, 0, 0); } while (0)
#define PG8_LDA(dst, b, h) do { _Pragma("unroll") for (int m = 0; m < 4; ++m) _Pragma("unroll") for (int k = 0; k < 2; ++k) dst[m][k] = *(const PG8_LAS bf16x8*)(lds + PG8_SA(b, h) + aoff + m * 2048 + k * 1024); } while (0)
#define PG8_LDB(dst, b, h) do { _Pragma("unroll") for (int n = 0; n < 2; ++n) _Pragma("unroll") for (int k = 0; k < 2; ++k) dst[n][k] = *(const PG8_LAS bf16x8*)(lds + PG8_SB(b, h) + boff + n * 2048 + k * 1024); } while (0)
#define PG8_MMA(ai, bj, At, Bt) do { __builtin_amdgcn_s_setprio(1); _Pragma("unroll") for (int m = 0; m < 4; ++m) _Pragma("unroll") for (int n = 0; n < 2; ++n) _Pragma("unroll") for (int k = 0; k < 2; ++k) \
        acc[ai][bj][m][n] = __builtin_amdgcn_mfma_f32_16x16x32_bf16(Bt[n][k], At[m][k], acc[ai][bj][m][n], 0, 0, 0); __builtin_amdgcn_s_setprio(0); } while (0)
#define PG8_WAIT_V(n) asm volatile("s_waitcnt vmcnt(" #n ")" ::: "memory")
#define PG8_WAIT_L(n) asm volatile("s_waitcnt lgkmcnt(" #n ")" ::: "memory")
#define PG8_BAR __builtin_amdgcn_s_barrier()
#define PG8_SCHED __builtin_amdgcn_sched_barrier(0)
    Unit cur, nxt; int ui = 0;
    if (!S.next(0, cur)) return;
    f32x4 acc[2][2][4][2];
#pragma unroll
    for (int a = 0; a < 2; ++a)
#pragma unroll
        for (int b = 0; b < 2; ++b)
#pragma unroll
            for (int m = 0; m < 4; ++m)
#pragma unroll
                for (int n = 0; n < 2; ++n) acc[a][b][m][n] = (f32x4){0.f, 0.f, 0.f, 0.f};
    bf16x8 At[4][2], B0[2][2], B1[2][2];
    const char* cA = (const char*)g.A + (size_t)cur.pm * tstep; const char* cB = (const char*)g.Bt + (size_t)cur.pn * tstep;
    S.a_ready(cur);
    if constexpr (SP2) {
        PG8_STAGE(PG8_SB(0, 0), cB, voffB); PG8_STAGE(PG8_SB(0, 1), cB + hstep, voffB); PG8_STAGE(PG8_SA(0, 0), cA, voffA); PG8_STAGE(PG8_SA(0, 1), cA + hstep, voffA);
        if (wr == 1) PG8_BAR;
        PG8_WAIT_V(2); PG8_BAR;
        PG8_STAGE(PG8_SB(1, 0), cB + kstep, voffB); PG8_STAGE(PG8_SA(1, 0), cA + kstep, voffA); PG8_STAGE(PG8_SB(1, 1), cB + hstep + kstep, voffB);
        PG8_WAIT_V(6); PG8_BAR;
    } else {
        PG8_STAGE(PG8_SB(0, 0), cB, voffB); PG8_STAGE(PG8_SA(0, 0), cA, voffA); PG8_STAGE(PG8_SB(0, 1), cB + hstep, voffB); PG8_STAGE(PG8_SA(0, 1), cA + hstep, voffA);
        if (wr == 1) PG8_BAR;
        PG8_WAIT_V(4); PG8_BAR;
        PG8_STAGE(PG8_SB(1, 0), cB + kstep, voffB); PG8_STAGE(PG8_SA(1, 0), cA + kstep, voffA); PG8_STAGE(PG8_SB(1, 1), cB + hstep + kstep, voffB);
        PG8_WAIT_V(6); PG8_BAR;
    }
    for (;;) {
        const bool has_next = S.next(ui + 1, nxt);
        const char* nA = has_next ? (const char*)g.A + (size_t)nxt.pm * tstep : cA; const char* nB = has_next ? (const char*)g.Bt + (size_t)nxt.pn * tstep : cB;
        for (int t = 0; t < nt; t += 2) {
            const bool last = (t == nt - 2);
            const char* a1 = cA + (size_t)(t + 1) * kstep;
            const char* a2 = last ? nA : cA + (size_t)(t + 2) * kstep; const char* b2 = last ? nB : cB + (size_t)(t + 2) * kstep;
            const char* a3 = a2 + kstep; const char* b3 = b2 + kstep;
            if (last && has_next) S.a_ready(nxt);
            if constexpr (SP2) {
            PG8_LDB(B0, 0, 0); PG8_LDB(B1, 0, 1); PG8_SCHED; PG8_LDA(At, 0, 0); PG8_STAGE(PG8_SA(1, 1), a1 + hstep, voffA);
            PG8_WAIT_V(8); PG8_WAIT_L(0); PG8_BAR; PG8_MMA(0, 0, At, B0); PG8_MMA(0, 1, At, B1); PG8_BAR; PG8_SCHED;
            PG8_LDA(At, 0, 1); PG8_STAGE(PG8_SB(0, 0), b2, voffB); PG8_STAGE(PG8_SB(0, 1), b2 + hstep, voffB); PG8_STAGE(PG8_SA(0, 0), a2, voffA);
            PG8_WAIT_V(8); PG8_WAIT_L(0); PG8_BAR; PG8_MMA(1, 0, At, B0); PG8_MMA(1, 1, At, B1); PG8_BAR; PG8_SCHED;
            PG8_LDB(B0, 1, 0); PG8_LDB(B1, 1, 1); PG8_SCHED; PG8_LDA(At, 1, 0); PG8_STAGE(PG8_SA(0, 1), a2 + hstep, voffA);
            PG8_WAIT_V(8); PG8_WAIT_L(0); PG8_BAR; PG8_MMA(0, 0, At, B0); PG8_MMA(0, 1, At, B1); PG8_BAR; PG8_SCHED;
            PG8_LDA(At, 1, 1); PG8_STAGE(PG8_SB(1, 0), b3, voffB); PG8_STAGE(PG8_SB(1, 1), b3 + hstep, voffB); PG8_STAGE(PG8_SA(1, 0), a3, voffA);
            PG8_WAIT_V(8); PG8_WAIT_L(0); PG8_BAR; PG8_MMA(1, 0, At, B0); PG8_MMA(1, 1, At, B1); PG8_BAR; PG8_SCHED;
            } else {
            PG8_LDB(B0, 0, 0); PG8_SCHED; PG8_LDA(At, 0, 0); PG8_STAGE(PG8_SA(1, 1), a1 + hstep, voffA);
            PG8_WAIT_L(8); PG8_BAR; PG8_WAIT_L(0); PG8_MMA(0, 0, At, B0); PG8_BAR; PG8_SCHED;
            PG8_LDB(B1, 0, 1); PG8_STAGE(PG8_SB(0, 0), b2, voffB);
            PG8_BAR; PG8_WAIT_L(0); PG8_MMA(0, 1, At, B1); PG8_BAR;
            PG8_LDA(At, 0, 1); PG8_STAGE(PG8_SA(0, 0), a2, voffA);
            PG8_BAR; PG8_WAIT_L(0); PG8_MMA(1, 0, At, B0); PG8_BAR; PG8_SCHED;
            PG8_STAGE(PG8_SB(0, 1), b2 + hstep, voffB);
            PG8_WAIT_V(6); PG8_BAR; PG8_MMA(1, 1, At, B1); PG8_BAR;
            PG8_LDB(B0, 1, 0); PG8_SCHED; PG8_LDA(At, 1, 0); PG8_STAGE(PG8_SA(0, 1), a2 + hstep, voffA);
            PG8_WAIT_L(8); PG8_BAR; PG8_WAIT_L(0); PG8_MMA(0, 0, At, B0); PG8_BAR; PG8_SCHED;
            PG8_LDB(B1, 1, 1); PG8_STAGE(PG8_SB(1, 0), b3, voffB);
            PG8_BAR; PG8_WAIT_L(0); PG8_MMA(0, 1, At, B1); PG8_BAR;
            PG8_LDA(At, 1, 1); PG8_STAGE(PG8_SA(1, 0), a3, voffA);
            PG8_BAR; PG8_WAIT_L(0); PG8_MMA(1, 0, At, B0); PG8_BAR; PG8_SCHED;
            PG8_STAGE(PG8_SB(1, 1), b3 + hstep, voffB);
            PG8_WAIT_V(6); PG8_BAR; PG8_MMA(1, 1, At, B1); PG8_BAR;
            }
        }
        if constexpr (ALIGN_EPI) { if (wr == 0) PG8_BAR; }
        if constexpr (!Epi::AFTER_DRAIN) { E(acc, cur, wr, wc, fr, fq); S.done(cur); }
        if (!has_next) break;
#pragma unroll
        for (int a = 0; a < 2; ++a)
#pragma unroll
            for (int b = 0; b < 2; ++b)
#pragma unroll
                for (int m = 0; m < 4; ++m)
#pragma unroll
                    for (int n = 0; n < 2; ++n) acc[a][b][m][n] = (f32x4){0.f, 0.f, 0.f, 0.f};
        cur = nxt; cA = nA; cB = nB; ++ui;
        if constexpr (ALIGN_EPI) { if (wr == 1) PG8_BAR; }
    }
    PG8_WAIT_V(0);
    if constexpr (!ALIGN_EPI) { if (wr == 0) PG8_BAR; }
    PG8_BAR;
    if constexpr (Epi::AFTER_DRAIN) { E.fused(acc, cur, wr, wc, fr, fq, lds, wid, lane); S.done(cur); }
#undef PG8_SA
#undef PG8_SB
#undef PG8_STAGE
#undef PG8_LDA
#undef PG8_LDB
#undef PG8_MMA
#undef PG8_WAIT_V
#undef PG8_WAIT_L
#undef PG8_BAR
#undef PG8_SCHED
}
}

constexpr int NWAVES = 8, NTHR = NWAVES * 64;
constexpr int DM = 1024, NBATCH = 8, SEQ = 4096, MROWS = NBATCH * SEQ;
constexpr int DFF = 4096, INW = 3864, INP = 4096, NMOD = 6 * DM;
constexpr float EPS = 1e-6f;
constexpr float QSCALE = 0.125f * 1.4426950408889634f;

typedef unsigned short bf16;
typedef unsigned u32x4 __attribute__((ext_vector_type(4)));
typedef float f32x4 __attribute__((ext_vector_type(4)));
typedef short bf16x8 __attribute__((ext_vector_type(8)));

constexpr size_t MiB = 1u << 20;
constexpr size_t WS_MOD = 1 * MiB;
constexpr size_t WS_CB = 1 * MiB + 512 * 1024;
constexpr size_t WS_COS = 2 * MiB, WS_SIN = 2 * MiB + 512 * 1024;
constexpr size_t WS_SELM = 3 * MiB;
constexpr size_t WS_KCC = 4 * MiB, WS_VCC = 5 * MiB;
constexpr size_t WS_WIN = 8 * MiB, WS_WA = 16 * MiB, WS_WB = 17 * MiB, WS_WOUT = 18 * MiB, WS_W1 = 20 * MiB, WS_W2 = 28 * MiB, WS_W1K = 36 * MiB, WS_W1V = 36 * MiB + 512 * 1024;
constexpr size_t WS_XN = 40 * MiB;
constexpr size_t WS_POOLED = 40 * MiB;
constexpr size_t WS_Y = 104 * MiB;
constexpr size_t WS_NG = 234 * MiB;
constexpr size_t WS_Q = 240 * MiB;
constexpr size_t WS_KV6 = 272 * MiB;
constexpr size_t WS_U = 320 * MiB;
constexpr size_t WS_BRG = 352 * MiB;
constexpr size_t WS_T1 = 272 * MiB;
constexpr size_t WS_HFF = 240 * MiB;
constexpr size_t WS_END = 496 * MiB;

constexpr int LDS_BYTES = 147456;

struct Args { const float* in[22]; float* out; unsigned char* ws; int ph_lo, ph_hi; };

#define LDS_WAIT() asm volatile("s_waitcnt lgkmcnt(0)" ::: "memory")
__device__ __forceinline__ unsigned f2bf(float f) { unsigned u = __float_as_uint(f); return (u + 0x7fffu + ((u >> 16) & 1u)) >> 16; }
__device__ __forceinline__ unsigned pk2(float lo, float hi) { return f2bf(lo) | (f2bf(hi) << 16); }
__device__ __forceinline__ float bf2f(bf16 h) { return __uint_as_float((unsigned)h << 16); }
__device__ __forceinline__ float bflo(unsigned w) { return __uint_as_float(w << 16); }
__device__ __forceinline__ float bfhi(unsigned w) { return __uint_as_float(w & 0xffff0000u); }
__device__ __forceinline__ float wave_sum(float v) {
#pragma unroll
    for (int o = 1; o < 64; o <<= 1) v += __shfl_xor(v, o);
    return v;
}
__device__ __forceinline__ float wave_max(float v) {
#pragma unroll
    for (int o = 1; o < 64; o <<= 1) v = fmaxf(v, __shfl_xor(v, o));
    return v;
}

__device__ __forceinline__ int win_dest(int c) {
    if (c < 1280) {
        const bool roped = (c < 640) || (c >= 768 && c < 896) || (c >= 1024 && c < 1152);
        if (!roped) return c;
        const int d = c & 63, base = c & ~63;
        return base + (d < 32 ? 2 * d : 2 * (d - 32) + 1);
    }
    if (c < 1304) return 3840 + (c - 1280);
    return c - 24;
}
__device__ __forceinline__ void transpose_item(const float* __restrict__ W, int K, int N, bf16* WT, int mode, float* scr, int item, int lane) {
    const int nblk = (N + 31) / 32, kb = item / nblk, nb = item % nblk, k0 = 64 * kb, n0 = 32 * nb;
    {
        const int n = n0 + (lane & 31);
#pragma unroll 8
        for (int i = 0; i < 32; ++i) { const int kk = 2 * i + (lane >> 5); scr[kk * 33 + (lane & 31)] = (n < N) ? W[(size_t)(k0 + kk) * N + n] : 0.f; }
    }
    LDS_WAIT();
    const int c = lane & 7;
#pragma unroll
    for (int j = 0; j < 4; ++j) {
        const int nl = (lane >> 3) + 8 * j, n = n0 + nl;
        float v[8];
#pragma unroll
        for (int e = 0; e < 8; ++e) { const int kk = (mode == 2) ? ((e & 1) * 32 + 4 * c + (e >> 1)) : (8 * c + e); v[e] = scr[kk * 33 + nl]; }
        if (n < N) {
            const int dr = (mode == 1) ? win_dest(n) : n;
            u32x4 o; o.x = pk2(v[0], v[1]); o.y = pk2(v[2], v[3]); o.z = pk2(v[4], v[5]); o.w = pk2(v[6], v[7]);
            *(u32x4*)(WT + (size_t)dr * K + k0 + 8 * c) = o;
        }
    }
    LDS_WAIT();
}

__device__ __forceinline__ void phase_p0(const Args& a, unsigned char* lds, int tid, int lane, int wave) {
    unsigned char* ws = a.ws;
    const int bid = blockIdx.x, G = gridDim.x;
    for (int job = bid; job < 98; job += G) {
        float* sl = (float*)lds; float* red = (float*)(lds + 32768);
        if (job < 96) {
            const float* c = a.in[1]; const float* w_ada = a.in[2]; const float* b_ada = a.in[3];
            for (int i = tid; i < 8192; i += NTHR) { const float v = c[i]; sl[i] = v / (1.f + __expf(-v)); }
            __syncthreads();
            const int j = job * 64 + lane, kb = wave * 128;
            float acc[8];
#pragma unroll
            for (int b = 0; b < 8; ++b) acc[b] = 0.f;
#pragma unroll 4
            for (int kk = 0; kk < 128; ++kk) { const int k = kb + kk; const float w = w_ada[(size_t)k * NMOD + j];
#pragma unroll
                for (int b = 0; b < 8; ++b) acc[b] += sl[b * 1024 + k] * w; }
#pragma unroll
            for (int b = 0; b < 8; ++b) red[(wave * 8 + b) * 64 + lane] = acc[b];
            __syncthreads();
            { const int b = wave; float s = 0.f;
#pragma unroll
              for (int w = 0; w < 8; ++w) s += red[(w * 8 + b) * 64 + lane];
              ((float*)(ws + WS_MOD))[b * NMOD + j] = s + b_ada[j]; }
            __syncthreads();
        } else {
            const int kv = job - 96; const float* pe = a.in[kv ? 10 : 7]; const float* w1 = a.in[kv ? 11 : 8];
            float acc = 0.f;
            for (int kk = wave * 256; kk < wave * 256 + 256; ++kk) acc += pe[kk] * w1[(size_t)kk * 64 + lane];
            red[wave * 64 + lane] = acc;
            __syncthreads();
            if (wave == 0) { float s = 0.f;
#pragma unroll
                for (int w = 0; w < 8; ++w) s += red[w * 64 + lane];
                ((float*)(ws + WS_CB))[kv * 64 + lane] = s; }
            __syncthreads();
        }
    }
    const int gw = bid * NWAVES + wave, NGW = G * NWAVES, gt = bid * NTHR + tid, NGT = G * NTHR;
    for (int e = gt; e < SEQ * 32; e += NGT) {
        const int t = e >> 5, i = e & 31;
        const float inv = powf(10000.0f, -(float)i / 32.0f);
        const float ang = (float)t * inv;
        const double ad = (double)ang;
        const double k = rint(ad * 0.15915494309189535);
        const float r = (float)(ad - k * 6.283185307179586);
        ((float*)(ws + WS_COS))[e] = cosf(r); ((float*)(ws + WS_SIN))[e] = sinf(r);
    }
    { u32x4 z = (u32x4){0u, 0u, 0u, 0u}; u32x4* p = (u32x4*)(ws + WS_WIN + (size_t)INW * DM * 2);
      for (int i = gt; i < (INP - INW) * DM * 2 / 16; i += NGT) p[i] = z;
      for (int i = gt; i < 2 * 16 * 8; i += NGT) { const int kv = i >> 7, bg = (i >> 3) & 15, ch = i & 7;
          *(u32x4*)(ws + (kv ? WS_VCC : WS_KCC) + ((size_t)(bg * 256 + 255) * 64 + ch * 8) * 2) = z; } }
    float* scr = (float*)(lds + wave * 16384);
    constexpr int I_IN = 16 * 121, I_A = 8 * 32, I_OUT = 16 * 32, I_1 = 16 * 128, I_2 = 64 * 32, I_CK = 32 * 2, I_CV = 32 * 2, I_WB = 1024;
    constexpr int NITEMS = I_IN + I_A + I_OUT + I_1 + I_2 + I_CK + I_CV + I_WB;
    for (int it = gw; it < NITEMS; it += NGW) {
        int r = it;
        if (r < I_IN) { transpose_item(a.in[6], 1024, INW, (bf16*)(ws + WS_WIN), 1, scr, r, lane); continue; } r -= I_IN;
        if (r < I_A) { transpose_item(a.in[15], 512, 1024, (bf16*)(ws + WS_WA), 0, scr, r, lane); continue; } r -= I_A;
        if (r < I_OUT) { transpose_item(a.in[17], 1024, 1024, (bf16*)(ws + WS_WOUT), 0, scr, r, lane); continue; } r -= I_OUT;
        if (r < I_1) { transpose_item(a.in[20], 1024, 4096, (bf16*)(ws + WS_W1), 0, scr, r, lane); continue; } r -= I_1;
        if (r < I_2) { transpose_item(a.in[21], 4096, 1024, (bf16*)(ws + WS_W2), 0, scr, r, lane); continue; } r -= I_2;
        if (r < I_CK) { transpose_item(a.in[8], 2048, 64, (bf16*)(ws + WS_W1K), 2, scr, r, lane); continue; } r -= I_CK;
        if (r < I_CV) { transpose_item(a.in[11], 2048, 64, (bf16*)(ws + WS_W1V), 0, scr, r, lane); continue; } r -= I_CV;
        {
            const float* w_pool = a.in[13]; const float* ps = a.in[14]; const float* wbr = a.in[16];
            const int kq = r >> 4, nb = r & 15, g = kq >> 4, c0 = (kq * 8) & 127, n = nb * 64 + lane;
            float acc[8];
#pragma unroll
            for (int e = 0; e < 8; ++e) acc[e] = 0.f;
            for (int d = 0; d < 128; ++d) {
                const float wb = wbr[(size_t)(g * 128 + d) * 1024 + n] * ps[g * 128 + d];
#pragma unroll
                for (int e = 0; e < 8; ++e) acc[e] += w_pool[(size_t)(g * 128 + c0 + e) * 128 + d] * wb;
            }
            u32x4 o; o.x = pk2(acc[0], acc[1]); o.y = pk2(acc[2], acc[3]); o.z = pk2(acc[4], acc[5]); o.w = pk2(acc[6], acc[7]);
            *(u32x4*)((bf16*)(ws + WS_WB) + (size_t)n * 512 + kq * 8) = o;
        }
    }
}

__device__ __forceinline__ void phase_norm_in(const Args& a, int lane, int wave) {
    const int gw = blockIdx.x * NWAVES + wave, NGW = gridDim.x * NWAVES;
    const float* x = a.in[0]; const float* g = a.in[4]; const float* mod = (const float*)(a.ws + WS_MOD); bf16* XN = (bf16*)(a.ws + WS_XN);
    for (int m = gw; m < MROWS; m += NGW) {
        const int b = m >> 12;
        const f32x4* xr = (const f32x4*)(x + (size_t)m * DM) + lane;
        f32x4 v[4]; float s = 0.f;
#pragma unroll
        for (int j = 0; j < 4; ++j) { v[j] = xr[64 * j]; s += (v[j].x * v[j].x + v[j].y * v[j].y) + (v[j].z * v[j].z + v[j].w * v[j].w); }
        const float rstd = rsqrtf(wave_sum(s) * (1.f / DM) + EPS);
        unsigned long long* o8 = (unsigned long long*)(XN + (size_t)m * DM) + lane;
#pragma unroll
        for (int j = 0; j < 4; ++j) {
            const int c = 4 * lane + 256 * j;
            const f32x4 gg = *(const f32x4*)(g + c), sh = *(const f32x4*)(mod + b * NMOD + c), sc = *(const f32x4*)(mod + b * NMOD + DM + c);
            const f32x4 h = v[j] * rstd * gg * (sc + 1.0f) + sh;
            o8[64 * j] = (unsigned long long)pk2(h.x, h.y) | ((unsigned long long)pk2(h.z, h.w) << 32);
        }
    }
}

__device__ __forceinline__ float gelu_tanh(float x) {
    const float z = 0.7978845608028654f * (x + 0.044715f * x * x * x);
    const float e = __expf(2.f * z);
    const float th = 1.f - 2.f / (e + 1.f);
    return 0.5f * x * (1.f + th);
}
__device__ __forceinline__ void phase_compress_pool(const Args& a, unsigned char* lds, int tid, int lane, int wave) {
    unsigned char* ws = a.ws;
    const int gw = blockIdx.x * NWAVES + wave, NGW = gridDim.x * NWAVES;
    const bf16* KV6 = (const bf16*)(ws + WS_KV6);
    float* hbuf = (float*)(lds + wave * 4096);
    for (int job = gw; job < 512; job += NGW) {
        const int nt = job & 15, g = (job >> 4) & 1, b = (job >> 5) & 7, kv = job >> 8;
        const bf16* W1T = (const bf16*)(ws + (kv ? WS_W1V : WS_W1K));
        const float* w2 = a.in[kv ? 12 : 9]; const float* cb = (const float*)(ws + WS_CB) + kv * 64;
        const int fr = lane & 15, fq = lane >> 4;
        const bf16* Ab = KV6 + (size_t)(b * SEQ + 16 * (nt * 16 + fr)) * 768 + kv * 128 + g * 64 + 8 * fq;
        const bf16* Bb = W1T + (size_t)fr * 2048 + 8 * fq;
        f32x4 acc[4];
#pragma unroll
        for (int nn = 0; nn < 4; ++nn) acc[nn] = (f32x4){0.f, 0.f, 0.f, 0.f};
#pragma unroll 4
        for (int kk = 0; kk < 64; ++kk) {
            const bf16x8 af = *(const bf16x8*)(Ab + (size_t)(kk >> 1) * 768 + (kk & 1) * 32);
#pragma unroll
            for (int nn = 0; nn < 4; ++nn) {
                const bf16x8 bfr = *(const bf16x8*)(Bb + (size_t)nn * 16 * 2048 + kk * 32);
                acc[nn] = __builtin_amdgcn_mfma_f32_16x16x32_bf16(af, bfr, acc[nn], 0, 0, 0);
            }
        }
#pragma unroll
        for (int nn = 0; nn < 4; ++nn) { const int col = nn * 16 + fr; const float bias = cb[col];
#pragma unroll
            for (int r = 0; r < 4; ++r) hbuf[(fq * 4 + r) * 64 + col] = gelu_tanh(acc[nn][r] + bias); }
        LDS_WAIT();
        float w2c[64];
#pragma unroll
        for (int k = 0; k < 64; ++k) w2c[k] = w2[k * 64 + lane];
        bf16* OUT = (bf16*)(ws + (kv ? WS_VCC : WS_KCC)) + (size_t)((b * 2 + g) * 256) * 64;
        const int ocol = kv ? lane : ((lane < 32) ? 2 * lane : 2 * (lane - 32) + 1);
        for (int r = 0; r < 16; ++r) {
            float s = 0.f;
#pragma unroll
            for (int k = 0; k < 64; ++k) s += hbuf[r * 64 + k] * w2c[k];
            const int n = nt * 16 + r;
            if (n < 255) OUT[(size_t)n * 64 + ocol] = (bf16)f2bf(s);
        }
        LDS_WAIT();
    }
    const bf16* U = (const bf16*)(ws + WS_U); bf16* P = (bf16*)(ws + WS_POOLED);
    const int gt = blockIdx.x * NTHR + tid, NGT = gridDim.x * NTHR;
    for (int idx = gt; idx < MROWS * 64; idx += NGT) {
        const int row = idx >> 6, c8 = idx & 63, t = row & (SEQ - 1), w = 2 << (c8 >> 4), cnt = (t + 1 < w) ? (t + 1) : w;
        float s[8], u0[8];
#pragma unroll
        for (int e = 0; e < 8; ++e) s[e] = 0.f;
        for (int j = 0; j < cnt; ++j) {
            const u32x4 q = *(const u32x4*)(U + (size_t)(row - j) * 512 + c8 * 8);
            const float f[8] = {bflo(q.x), bfhi(q.x), bflo(q.y), bfhi(q.y), bflo(q.z), bfhi(q.z), bflo(q.w), bfhi(q.w)};
#pragma unroll
            for (int e = 0; e < 8; ++e) { s[e] += f[e]; if (j == 0) u0[e] = f[e]; }
        }
        const float ic = 1.f / (float)cnt;
        u32x4 o; o.x = pk2(s[0] * ic - u0[0], s[1] * ic - u0[1]); o.y = pk2(s[2] * ic - u0[2], s[3] * ic - u0[3]);
        o.z = pk2(s[4] * ic - u0[4], s[5] * ic - u0[5]); o.w = pk2(s[6] * ic - u0[6], s[7] * ic - u0[7]);
        *(u32x4*)(P + (size_t)row * 512 + c8 * 8) = o;
    }
}


namespace nsa {
typedef __attribute__((address_space(3))) unsigned char lds_u8;
using s16x4 = __attribute__((ext_vector_type(4))) short;
using f32x16 = __attribute__((ext_vector_type(16))) float;
typedef float f32x2_t __attribute__((ext_vector_type(2))); typedef __bf16 bf16x2_t __attribute__((ext_vector_type(2)));
constexpr int A_K = 0, A_V = 16384, A_WS = 32768, A_OST = 34816, A_IMP = 67584, A_MSK = 83968, A_OV = 86016, A_END = A_OV + 4 * 8192;
static_assert(A_END <= 131072, "attention LDS map");
__device__ __forceinline__ int crow(int r, int hi) { return (r & 3) + 8 * (r >> 2) + 4 * hi; }
__device__ __forceinline__ void glds16(const void* gsrc, unsigned lds_dst) { unsigned keep;
    asm volatile("s_mov_b32 %0, m0\n\ts_mov_b32 m0, %2\n\ts_nop 0\n\tglobal_load_lds_dwordx4 %1, off\n\ts_mov_b32 m0, %0" : "=&s"(keep) : "v"(gsrc), "s"(lds_dst) : "memory"); }
__device__ __forceinline__ unsigned cvtpk(float lo, float hi) { f32x2_t v = {lo, hi}; bf16x2_t b = __builtin_convertvector(v, bf16x2_t); return __builtin_bit_cast(unsigned, b); }
#define NSA_WAIT_BAR() asm volatile("s_waitcnt vmcnt(0) lgkmcnt(0)\n\ts_barrier" ::: "memory")
__device__ __forceinline__ void qkt(f32x16& p0, f32x16& p1, const lds_u8* Kslot, const bf16x8 (&qr)[4], int r32, int hi) {
    const lds_u8* kb = Kslot + hi * 1024 + r32 * 16;
    p0 = f32x16{}; p1 = f32x16{};
#pragma unroll
    for (int d0 = 0; d0 < 4; ++d0) {
        const bf16x8 b0 = *(const __attribute__((address_space(3))) bf16x8*)(kb + d0 * 2048);
        const bf16x8 b1 = *(const __attribute__((address_space(3))) bf16x8*)(kb + d0 * 2048 + 512);
        p0 = __builtin_amdgcn_mfma_f32_32x32x16_bf16(b0, qr[d0], p0, 0, 0, 0);
        p1 = __builtin_amdgcn_mfma_f32_32x32x16_bf16(b1, qr[d0], p1, 0, 0, 0);
    }
}
__device__ __forceinline__ void pv(f32x16 (&o)[2], int vb, bf16x8 pa0, bf16x8 pa1, bf16x8 pa2, bf16x8 pa3) {
#pragma unroll
    for (int d0 = 0; d0 < 2; ++d0) { s16x4 lo[4], hi[4];
#pragma unroll
        for (int ks = 0; ks < 4; ++ks) {
            asm volatile("ds_read_b64_tr_b16 %0,%1 offset:%c2" : "=&v"(lo[ks]) : "v"(vb), "i"(d0 * 4096 + ks * 1024) : "memory");
            asm volatile("ds_read_b64_tr_b16 %0,%1 offset:%c2" : "=&v"(hi[ks]) : "v"(vb), "i"(d0 * 4096 + ks * 1024 + 512) : "memory"); }
        asm volatile("s_waitcnt lgkmcnt(0)" : "+v"(lo[0]), "+v"(lo[1]), "+v"(lo[2]), "+v"(lo[3]), "+v"(hi[0]), "+v"(hi[1]), "+v"(hi[2]), "+v"(hi[3]) :: "memory");
        __builtin_amdgcn_sched_barrier(0);
#define NSA_PK(k) (bf16x8){lo[k][0], lo[k][1], lo[k][2], lo[k][3], hi[k][0], hi[k][1], hi[k][2], hi[k][3]}
        o[d0] = __builtin_amdgcn_mfma_f32_32x32x16_bf16(pa0, NSA_PK(0), o[d0], 0, 0, 0);
        o[d0] = __builtin_amdgcn_mfma_f32_32x32x16_bf16(pa1, NSA_PK(1), o[d0], 0, 0, 0);
        o[d0] = __builtin_amdgcn_mfma_f32_32x32x16_bf16(pa2, NSA_PK(2), o[d0], 0, 0, 0);
        o[d0] = __builtin_amdgcn_mfma_f32_32x32x16_bf16(pa3, NSA_PK(3), o[d0], 0, 0, 0);
#undef NSA_PK
    }
}
__device__ __forceinline__ float half_max(float m) { auto rr = __builtin_amdgcn_permlane32_swap(__float_as_uint(m), __float_as_uint(m), false, false); return fmaxf(__uint_as_float(rr[0]), __uint_as_float(rr[1])); }
__device__ __forceinline__ float half_sum(float m) { auto rr = __builtin_amdgcn_permlane32_swap(__float_as_uint(m), __float_as_uint(m), false, false); return __uint_as_float(rr[0]) + __uint_as_float(rr[1]); }

template <int MODE>
__device__ __forceinline__ float run_pass(lds_u8* shm, unsigned lds0, const bf16* Kg, const bf16* Vg, int pitch, int tile0, int NT, const bf16x8 (&qr)[4],
                                          int lo, int hi_lim, unsigned long long selmask, f32x16 (&o)[2], f32x16 (&imp)[2], int lane, int wid) {
    const int r32 = lane & 31, hi = lane >> 5;
    float m_run = -100.f, l_reg = 0.f;
    o[0] = f32x16{}; o[1] = f32x16{}; if (MODE == 0) { imp[0] = f32x16{}; imp[1] = f32x16{}; }
    const bf16* ksrc = Kg + (size_t)lane * pitch + wid * 8;
    const bf16* vsrc = Vg + (size_t)(16 * (wid & 3) + (lane >> 2)) * pitch + (wid >> 2) * 32 + (lane & 3) * 8;
    const unsigned kdst = lds0 + A_K + wid * 1024, vdst = lds0 + A_V + wid * 1024;
    volatile __attribute__((address_space(3))) float* wsf = (volatile __attribute__((address_space(3))) float*)(shm + A_WS) + wid * 64;
    const int vb0 = (int)(lds0 + A_V) + ((lane >> 4) & 1) * 32 + (lane & 3) * 8 + (4 * hi + ((lane & 15) >> 2)) * 64;
    const int ovb0 = (int)(lds0 + A_OV) + ((lane >> 4) & 1) * 32 + (lane & 3) * 8 + (4 * hi + ((lane & 15) >> 2)) * 64;
    glds16(ksrc + (size_t)tile0 * 64 * pitch, (unsigned)__builtin_amdgcn_readfirstlane(kdst));
    glds16(vsrc + (size_t)tile0 * 64 * pitch, (unsigned)__builtin_amdgcn_readfirstlane(vdst));
#pragma unroll 1
    for (int i = 0; i < NT; ++i) {
        const int slot = (i & 1) * 8192, tile = tile0 + i;
        NSA_WAIT_BAR();
        if (i + 1 < NT) {
            glds16(ksrc + (size_t)(tile + 1) * 64 * pitch, (unsigned)__builtin_amdgcn_readfirstlane(kdst + (slot ^ 8192)));
            glds16(vsrc + (size_t)(tile + 1) * 64 * pitch, (unsigned)__builtin_amdgcn_readfirstlane(vdst + (slot ^ 8192)));
        }
        f32x16 p0, p1;
        qkt(p0, p1, shm + A_K + slot, qr, r32, hi);
        {
            const bool need_range = (MODE == 0) || (i == NT - 1) || (MODE == 2 && i == 0);
            if (need_range) {
                const int a = lo - (tile * 64 + 4 * hi), bb = hi_lim - (tile * 64 + 4 * hi);
#pragma unroll
                for (int r = 0; r < 16; ++r) { const int c = (r & 3) + 8 * (r >> 2);
                    if (c < a || c > bb) p0[r] = -INFINITY;
                    if (c + 32 < a || c + 32 > bb) p1[r] = -INFINITY; }
            }
            if (MODE == 1) { if (!((selmask >> tile) & 1ull)) {
#pragma unroll
                for (int r = 0; r < 16; ++r) { p0[r] = -INFINITY; p1[r] = -INFINITY; } } }
        }
        float rm = p0[0];
#pragma unroll
        for (int r = 1; r < 16; ++r) rm = fmaxf(rm, p0[r]);
#pragma unroll
        for (int r = 0; r < 16; ++r) rm = fmaxf(rm, p1[r]);
        rm = half_max(rm);
        const float mnew = fmaxf(m_run, rm), alpha = __builtin_amdgcn_exp2f(m_run - mnew);
        m_run = mnew;
        float sum = 0.f;
#pragma unroll
        for (int r = 0; r < 16; ++r) { p0[r] = __builtin_amdgcn_exp2f(p0[r] - mnew); p1[r] = __builtin_amdgcn_exp2f(p1[r] - mnew); sum += p0[r] + p1[r]; }
        l_reg = l_reg * alpha + sum;
        if (__any(alpha != 1.f)) {
            if (hi == 0) wsf[r32] = alpha;
            asm volatile("s_waitcnt lgkmcnt(0)" ::: "memory");
#pragma unroll
            for (int r = 0; r < 16; ++r) { const float f = wsf[crow(r, hi)]; o[0][r] *= f; o[1][r] *= f; if (MODE == 0) { imp[0][r] *= f; imp[1][r] *= f; } }
        }
        u32x4 pw0, pw1, pw2, pw3;
        pw0 = (u32x4){cvtpk(p0[0], p0[1]), cvtpk(p0[2], p0[3]), cvtpk(p0[4], p0[5]), cvtpk(p0[6], p0[7])};
        pw1 = (u32x4){cvtpk(p0[8], p0[9]), cvtpk(p0[10], p0[11]), cvtpk(p0[12], p0[13]), cvtpk(p0[14], p0[15])};
        pw2 = (u32x4){cvtpk(p1[0], p1[1]), cvtpk(p1[2], p1[3]), cvtpk(p1[4], p1[5]), cvtpk(p1[6], p1[7])};
        pw3 = (u32x4){cvtpk(p1[8], p1[9]), cvtpk(p1[10], p1[11]), cvtpk(p1[12], p1[13]), cvtpk(p1[14], p1[15])};
        pv(o, vb0 + slot, __builtin_bit_cast(bf16x8, pw0), __builtin_bit_cast(bf16x8, pw1), __builtin_bit_cast(bf16x8, pw2), __builtin_bit_cast(bf16x8, pw3));
        if (MODE == 0) {
            pv(imp, ovb0 + tile * 8192, __builtin_bit_cast(bf16x8, pw0), __builtin_bit_cast(bf16x8, pw1), __builtin_bit_cast(bf16x8, pw2), __builtin_bit_cast(bf16x8, pw3));
            u32x4 q0, q1, q2, q3;
#define NSA_LO(P, W, a) cvtpk(P[a] - __uint_as_float(W << 16), P[a + 1] - __uint_as_float(W & 0xffff0000u))
            q0 = (u32x4){NSA_LO(p0, pw0[0], 0), NSA_LO(p0, pw0[1], 2), NSA_LO(p0, pw0[2], 4), NSA_LO(p0, pw0[3], 6)};
            q1 = (u32x4){NSA_LO(p0, pw1[0], 8), NSA_LO(p0, pw1[1], 10), NSA_LO(p0, pw1[2], 12), NSA_LO(p0, pw1[3], 14)};
            q2 = (u32x4){NSA_LO(p1, pw2[0], 0), NSA_LO(p1, pw2[1], 2), NSA_LO(p1, pw2[2], 4), NSA_LO(p1, pw2[3], 6)};
            q3 = (u32x4){NSA_LO(p1, pw3[0], 8), NSA_LO(p1, pw3[1], 10), NSA_LO(p1, pw3[2], 12), NSA_LO(p1, pw3[3], 14)};
#undef NSA_LO
            pv(imp, ovb0 + tile * 8192, __builtin_bit_cast(bf16x8, q0), __builtin_bit_cast(bf16x8, q1), __builtin_bit_cast(bf16x8, q2), __builtin_bit_cast(bf16x8, q3));
        }
    }
    NSA_WAIT_BAR();
    return half_sum(l_reg);
}

__device__ __forceinline__ void unit(lds_u8* shm, unsigned lds0, unsigned char* ws, int b, int g, int qb, int lane, int wid) {
    const int r32 = lane & 31, hi = lane >> 5;
    const int q0 = qb * 64; const size_t rowbase = (size_t)b * SEQ;
    const int tq = q0 + 8 * wid + (r32 >> 2), head = g * 4 + (r32 & 3);
    const bf16* Qp = (const bf16*)(ws + WS_Q) + (rowbase + tq) * 512 + head * 64;
    bf16x8 qr[4];
#pragma unroll
    for (int d0 = 0; d0 < 4; ++d0) qr[d0] = *(const bf16x8*)(Qp + d0 * 16 + hi * 8);
    const float* ng = (const float*)(ws + WS_NG) + (rowbase + tq) * 24 + head * 3;
    const float g0 = ng[0], g1 = ng[1], g2 = ng[2];
    volatile __attribute__((address_space(3))) float* wsf = (volatile __attribute__((address_space(3))) float*)(shm + A_WS) + wid * 64;
    volatile __attribute__((address_space(3))) float* impw = (volatile __attribute__((address_space(3))) float*)(shm + A_IMP) + wid * 512;
    volatile __attribute__((address_space(3))) unsigned long long* mskw = (volatile __attribute__((address_space(3))) unsigned long long*)(shm + A_MSK) + wid * 8;
    f32x16 ot[2], o[2], imp[2];
    const bf16* KV6 = (const bf16*)(ws + WS_KV6) + rowbase * 768;
    {
        const int nvis = (tq >= 31) ? (((tq - 31) >> 4) + 1) : 0;
        const int NTc = (4 * qb + 3 + 63) >> 6;
        const bf16* Kc = (const bf16*)(ws + WS_KCC) + (size_t)((b * 2 + g) * 256) * 64;
        const bf16* Vc = (const bf16*)(ws + WS_VCC) + (size_t)((b * 2 + g) * 256) * 64;
        const float l = run_pass<0>(shm, lds0, Kc, Vc, 64, 0, NTc, qr, 0, nvis - 1, 0ull, o, imp, lane, wid);
        const float rl = (l > 0.f) ? 1.f / l : 0.f;
        if (hi == 0) { wsf[r32] = g0 * rl; wsf[32 + r32] = rl; }
        asm volatile("s_waitcnt lgkmcnt(0)" ::: "memory");
#pragma unroll
        for (int r = 0; r < 16; ++r) { const float f = wsf[crow(r, hi)]; ot[0][r] = o[0][r] * f; ot[1][r] = o[1][r] * f; }
#pragma unroll
        for (int k = 0; k < 4; ++k) {
            const float f0 = wsf[32 + crow(4 * k, hi)], f1 = wsf[32 + crow(4 * k + 1, hi)], f2 = wsf[32 + crow(4 * k + 2, hi)], f3 = wsf[32 + crow(4 * k + 3, hi)];
#pragma unroll
            for (int d0 = 0; d0 < 2; ++d0)
                impw[(2 * k + hi) * 64 + d0 * 32 + r32] = ((imp[d0][4 * k] * f0 + imp[d0][4 * k + 1] * f1) + imp[d0][4 * k + 2] * f2) + imp[d0][4 * k + 3] * f3;
        }
        asm volatile("s_waitcnt lgkmcnt(0)" ::: "memory");
    }
    if (qb >= 16) {
        const bool causal = lane <= qb, forced = (lane == 0) || (lane == qb) || (lane == qb - 1);
        for (int ql = 0; ql < 8; ++ql) {
            const float v = impw[ql * 64 + lane];
            const float val = forced ? 1e9f : (causal ? v : -INFINITY);
            int rank = 0;
            for (int j = 0; j < 64; ++j) { const float vj = __shfl(val, j); rank += ((vj > val) || (vj == val && j < lane)) ? 1 : 0; }
            const unsigned long long mk = __ballot((rank < 16) && causal);
            if (lane == 0) mskw[ql] = mk;
        }
    } else {
        if (lane < 8) mskw[lane] = (2ull << qb) - 1ull;
    }
    asm volatile("s_waitcnt lgkmcnt(0)" ::: "memory");
    const unsigned long long selmask = mskw[r32 >> 2];
    {
        const float l = run_pass<1>(shm, lds0, KV6 + 256 + g * 64, KV6 + 384 + g * 64, 768, 0, qb + 1, qr, 0, tq, selmask, o, imp, lane, wid);
        if (hi == 0) wsf[r32] = g1 / l;
        asm volatile("s_waitcnt lgkmcnt(0)" ::: "memory");
#pragma unroll
        for (int r = 0; r < 16; ++r) { const float f = wsf[crow(r, hi)]; ot[0][r] += o[0][r] * f; ot[1][r] += o[1][r] * f; }
        asm volatile("s_waitcnt lgkmcnt(0)" ::: "memory");
    }
    {
        const int t0 = (qb >= 8) ? qb - 8 : 0;
        const float l = run_pass<2>(shm, lds0, KV6 + 512 + g * 64, KV6 + 640 + g * 64, 768, t0, qb - t0 + 1, qr, tq - 511, tq, 0ull, o, imp, lane, wid);
        if (hi == 0) wsf[r32] = g2 / l;
        asm volatile("s_waitcnt lgkmcnt(0)" ::: "memory");
#pragma unroll
        for (int r = 0; r < 16; ++r) { const float f = wsf[crow(r, hi)]; ot[0][r] += o[0][r] * f; ot[1][r] += o[1][r] * f; }
    }
    {
        __attribute__((address_space(3))) bf16* stg = (__attribute__((address_space(3))) bf16*)(shm + A_OST) + wid * 2048;
#pragma unroll
        for (int r = 0; r < 16; ++r) { const int orow = crow(r, hi);
#pragma unroll
            for (int d0 = 0; d0 < 2; ++d0) stg[orow * 64 + d0 * 32 + r32] = (bf16)f2bf(ot[d0][r]); }
        asm volatile("s_waitcnt lgkmcnt(0)" ::: "memory");
        bf16* O = (bf16*)(ws + WS_Q);
#pragma unroll
        for (int i = 0; i < 4; ++i) { const int row = i * 8 + (lane >> 3), ch = lane & 7;
            const u32x4 v = *(const __attribute__((address_space(3))) u32x4*)(stg + row * 64 + ch * 8);
            *(u32x4*)(O + (rowbase + q0 + 8 * wid + (row >> 2)) * 512 + (g * 4 + (row & 3)) * 64 + ch * 8) = v; }
        asm volatile("s_waitcnt lgkmcnt(0)" ::: "memory");
    }
}

__device__ __forceinline__ void phase(unsigned char* lds, unsigned char* ws, int tid, int lane, int wid) {
    lds_u8* shm = (lds_u8*)lds;
    const unsigned lds0 = (unsigned)(uintptr_t)lds;
    for (int e = tid; e < 4 * 64 * 64; e += NTHR) {
        const int j = e >> 12, nl = (e >> 6) & 63, m = e & 63, n = 64 * j + nl;
        const bool on = (n >= 4 * m - 1) && (n <= 4 * m + 3);
        *(__attribute__((address_space(3))) bf16*)(shm + A_OV + j * 8192 + ((m >> 5) * 4 + (nl >> 4)) * 1024 + (nl & 15) * 64 + (m & 31) * 2) = on ? (bf16)0x3F80 : (bf16)0;
    }
    __syncthreads();
    const int G = gridDim.x, bid = blockIdx.x;
    if (G == 256) {
        const int vcu = (bid & 7) * 32 + (bid >> 3), bg = vcu >> 4, s = vcu & 15;
#pragma unroll 1
        for (int i = 0; i < 4; ++i) { const int qb = (i == 0) ? 63 - s : (i == 1) ? 32 + s : (i == 2) ? 31 - s : s; unit(shm, lds0, ws, bg >> 1, bg & 1, qb, lane, wid); }
    } else {
#pragma unroll 1
        for (int u = bid; u < 1024; u += G) unit(shm, lds0, ws, u >> 7, (u >> 6) & 1, 63 - (u & 63), lane, wid);
    }
}
#undef NSA_WAIT_BAR
}

__device__ __forceinline__ void phase_mid_norm(const Args& a, int lane, int wave) {
    const int gw = blockIdx.x * NWAVES + wave, NGW = gridDim.x * NWAVES;
    const float* x = a.in[0]; const float* gpost = a.in[5]; const float* gpre = a.in[18];
    const float* mod = (const float*)(a.ws + WS_MOD); const float* Y = (const float*)(a.ws + WS_Y); bf16* XN = (bf16*)(a.ws + WS_XN);
    for (int m = gw; m < MROWS; m += NGW) {
        const int b = m >> 12; const float* mb = mod + b * NMOD;
        const f32x4* yr = (const f32x4*)(Y + (size_t)m * DM) + lane; const f32x4* xr = (const f32x4*)(x + (size_t)m * DM) + lane;
        f32x4 v[4]; float s = 0.f;
#pragma unroll
        for (int j = 0; j < 4; ++j) { v[j] = yr[64 * j]; s += (v[j].x * v[j].x + v[j].y * v[j].y) + (v[j].z * v[j].z + v[j].w * v[j].w); }
        const float rstd = rsqrtf(wave_sum(s) * (1.f / DM) + EPS);
        float s2 = 0.f;
#pragma unroll
        for (int j = 0; j < 4; ++j) { const int c = 4 * lane + 256 * j;
            const f32x4 gg = *(const f32x4*)(gpost + c), gt = *(const f32x4*)(mb + 2 * DM + c);
            v[j] = xr[64 * j] + gt * (v[j] * rstd * gg);
            s2 += (v[j].x * v[j].x + v[j].y * v[j].y) + (v[j].z * v[j].z + v[j].w * v[j].w); }
        const float rstd2 = rsqrtf(wave_sum(s2) * (1.f / DM) + EPS);
        f32x4* orow = (f32x4*)(a.out + (size_t)m * DM) + lane;
        unsigned long long* o8 = (unsigned long long*)(XN + (size_t)m * DM) + lane;
#pragma unroll
        for (int j = 0; j < 4; ++j) { const int c = 4 * lane + 256 * j;
            orow[64 * j] = v[j];
            const f32x4 gg = *(const f32x4*)(gpre + c), sh = *(const f32x4*)(mb + 3 * DM + c), sc = *(const f32x4*)(mb + 4 * DM + c);
            const f32x4 h = v[j] * rstd2 * gg * (sc + 1.0f) + sh;
            o8[64 * j] = (unsigned long long)pk2(h.x, h.y) | ((unsigned long long)pk2(h.z, h.w) << 32); }
    }
}
__device__ __forceinline__ void phase_final_norm(const Args& a, int lane, int wave) {
    const int gw = blockIdx.x * NWAVES + wave, NGW = gridDim.x * NWAVES;
    const float* gpost = a.in[19]; const float* mod = (const float*)(a.ws + WS_MOD); const float* Y = (const float*)(a.ws + WS_Y);
    for (int m = gw; m < MROWS; m += NGW) {
        const int b = m >> 12; const float* mb = mod + b * NMOD;
        const f32x4* yr = (const f32x4*)(Y + (size_t)m * DM) + lane; f32x4* orow = (f32x4*)(a.out + (size_t)m * DM) + lane;
        f32x4 v[4]; float s = 0.f;
#pragma unroll
        for (int j = 0; j < 4; ++j) { v[j] = yr[64 * j]; s += (v[j].x * v[j].x + v[j].y * v[j].y) + (v[j].z * v[j].z + v[j].w * v[j].w); }
        const float rstd = rsqrtf(wave_sum(s) * (1.f / DM) + EPS);
#pragma unroll
        for (int j = 0; j < 4; ++j) { const int c = 4 * lane + 256 * j;
            const f32x4 gg = *(const f32x4*)(gpost + c), gt = *(const f32x4*)(mb + 5 * DM + c);
            orow[64 * j] = orow[64 * j] + gt * (v[j] * rstd * gg); }
    }
}

constexpr int N_PHASES = 12;
__global__ void __launch_bounds__(NTHR, 2) fwd_kernel(Args a) {
    extern __shared__ __attribute__((aligned(16))) unsigned char lds[];
    cg::grid_group grid = cg::this_grid();
    const int tid = threadIdx.x, lane = tid & 63, wave = __builtin_amdgcn_readfirstlane(tid >> 6);
    unsigned char* ws = a.ws;
    const int lo = a.ph_lo, hi = a.ph_hi, G = gridDim.x, bid = blockIdx.x;
    PG8_LAS unsigned char* ldsg = (PG8_LAS unsigned char*)lds;
#define IN(k) (lo <= (k) && (k) < hi)
#define SEAM(k) do { if ((k) + 1 < hi) grid.sync(); } while (0)
    if (IN(0)) { phase_p0(a, lds, tid, lane, wave); SEAM(0); }
    if (IN(1)) { phase_norm_in(a, lane, wave); SEAM(1); }
    if (IN(2)) {
        pg8::Gemm g{(const bf16*)(ws + WS_XN), (const bf16*)(ws + WS_WIN), MROWS, INP, DM}; pg8::StaticOrder S; S.init(MROWS, INP, G, bid);
        pg8::EpiProj E{(bf16*)(ws + WS_Q), (bf16*)(ws + WS_KV6), (bf16*)(ws + WS_U), (bf16*)(ws + WS_BRG), (float*)(ws + WS_NG), (const float*)(ws + WS_COS), (const float*)(ws + WS_SIN), QSCALE};
        pg8::gemm_phase<pg8::EpiProj, pg8::StaticOrder, true, true>(ldsg, g, S, E);
        SEAM(2);
    }
    if (IN(3)) { phase_compress_pool(a, lds, tid, lane, wave); SEAM(3); }
    if (IN(4)) { nsa::phase(lds, ws, tid, lane, wave); SEAM(4); }
    if (IN(5)) {
        pg8::Gemm g{(const bf16*)(ws + WS_Q), (const bf16*)(ws + WS_WA), MROWS, DM, 512}; pg8::StaticOrder S; S.init(MROWS, DM, G, bid);
        pg8::EpiGate<0> E{(bf16*)(ws + WS_T1), (const bf16*)(ws + WS_BRG)};
        pg8::gemm_phase<pg8::EpiGate<0>, pg8::StaticOrder, true, true>(ldsg, g, S, E);
        SEAM(5);
    }
    if (IN(6)) {
        pg8::Gemm g{(const bf16*)(ws + WS_POOLED), (const bf16*)(ws + WS_WB), MROWS, DM, 512}; pg8::StaticOrder S; S.init(MROWS, DM, G, bid);
        pg8::EpiGate<1> E{(bf16*)(ws + WS_T1), (const bf16*)(ws + WS_BRG) + 1024};
        pg8::gemm_phase<pg8::EpiGate<1>, pg8::StaticOrder, true, true>(ldsg, g, S, E);
        SEAM(6);
    }
    if (IN(7)) {
        pg8::Gemm g{(const bf16*)(ws + WS_T1), (const bf16*)(ws + WS_WOUT), MROWS, DM, DM}; pg8::StaticOrder S; S.init(MROWS, DM, G, bid);
        pg8::EpiF32 E{(float*)(ws + WS_Y), DM};
        pg8::gemm_phase<pg8::EpiF32, pg8::StaticOrder, true, true>(ldsg, g, S, E);
        SEAM(7);
    }
    if (IN(8)) { phase_mid_norm(a, lane, wave); SEAM(8); }
    if (IN(9)) {
        pg8::Gemm g{(const bf16*)(ws + WS_XN), (const bf16*)(ws + WS_W1), MROWS, DFF, DM}; pg8::StaticOrder S; S.init(MROWS, DFF, G, bid);
        pg8::EpiRelu2 E{(bf16*)(ws + WS_HFF), DFF};
        pg8::gemm_phase<pg8::EpiRelu2, pg8::StaticOrder, true, true>(ldsg, g, S, E);
        SEAM(9);
    }
    if (IN(10)) {
        pg8::Gemm g{(const bf16*)(ws + WS_HFF), (const bf16*)(ws + WS_W2), MROWS, DM, DFF}; pg8::StaticOrder S; S.init(MROWS, DM, G, bid);
        pg8::EpiF32 E{(float*)(ws + WS_Y), DM};
        pg8::gemm_phase<pg8::EpiF32, pg8::StaticOrder, true, true>(ldsg, g, S, E);
        SEAM(10);
    }
    if (IN(11)) { phase_final_norm(a, lane, wave); }
#undef IN
#undef SEAM
}

extern "C" void kernel_launch(void* const* d_in, const int* in_sizes, int n_in, void* d_out, int out_size, void* d_ws, size_t ws_size, hipStream_t stream) {
    static int grid = 0;
    if (grid == 0) {
        if (n_in != 22 || in_sizes[0] != MROWS * DM || out_size != MROWS * DM || ws_size < WS_END) {
            fprintf(stderr, "kernel_launch: unexpected shapes (n_in %d, in0 %d, out %d, ws %zu); nothing launched\n", n_in, n_in > 0 ? in_sizes[0] : -1, out_size, ws_size); grid = -1; return; }
        int dev = 0, cus = 0, per_cu = 0;
        if (hipGetDevice(&dev) != hipSuccess || hipDeviceGetAttribute(&cus, hipDeviceAttributeMultiprocessorCount, dev) != hipSuccess) { grid = -1; return; }
        if (hipFuncSetAttribute((const void*)fwd_kernel, hipFuncAttributeMaxDynamicSharedMemorySize, LDS_BYTES) != hipSuccess) { fprintf(stderr, "kernel_launch: hipFuncSetAttribute failed\n"); grid = -1; return; }
        if (hipOccupancyMaxActiveBlocksPerMultiprocessor(&per_cu, (const void*)fwd_kernel, NTHR, LDS_BYTES) != hipSuccess || per_cu < 1) { fprintf(stderr, "kernel_launch: occupancy query says %d blocks per CU\n", per_cu); grid = -1; (void)hipGetLastError(); return; }
        grid = cus;
    }
    if (grid < 0) return;
    Args a{};
    for (int i = 0; i < 22; ++i) a.in[i] = (const float*)d_in[i];
    a.out = (float*)d_out; a.ws = (unsigned char*)d_ws;
    constexpr int NL = MK_N_LAUNCHES;
    for (int li = 0; li < NL; ++li) {
        a.ph_lo = (NL == 1) ? 0 : li; a.ph_hi = (NL == 1) ? N_PHASES : li + 1;
        void* args[] = {&a};
        const hipError_t e = hipLaunchCooperativeKernel((const void*)fwd_kernel, dim3(grid), dim3(NTHR), args, LDS_BYTES, stream);
        if (e != hipSuccess) { fprintf(stderr, "kernel_launch: cooperative launch %d failed: %s (grid %d)\n", li, hipGetErrorString(e), grid); break; }
    }
}
```
